# Optimizing an MI355X kernel written in HIP

```python
import jax
import jax.numpy as jnp
from jax import lax
import numpy as np

D_MODEL = 2048
BATCH = 4
SEQ = 8192
DEPTH = 1

A_HEADS = 8
A_HEAD_DIM = 128
A_WIDTH = A_HEADS * A_HEAD_DIM
MOBA_BLOCK = 256
MOBA_TOPK = 3
MOBA_Q_CHUNK = 16
ROPE_THETA = 500000.0
ROPE_DIM = A_HEAD_DIM // 4
R_HEADS = 8
R_KEY_DIM = 128
R_VAL_DIM = 128
R_KWIDTH = R_HEADS * R_KEY_DIM
R_VWIDTH = R_HEADS * R_VAL_DIM
R_CHUNK = 64
N_BRANCH = 2
D_FF = 4 * D_MODEL
D_IN = 3 * A_WIDTH + 2 * R_KWIDTH + 2 * R_VWIDTH + N_BRANCH * D_MODEL
EPS = 1e-6

kernel_name = "hybrid_moba_hgrn2_gated_merge_block"


def _rmsnorm(x, g):
    x32 = x.astype(jnp.float32)
    y = x32 * lax.rsqrt(jnp.mean(x32 * x32, axis=-1, keepdims=True) + EPS)
    return y.astype(x.dtype) * g


def _rope_tables(seq, dtype):
    pos = jnp.arange(seq, dtype=jnp.float32)
    inv_freq = ROPE_THETA ** (-jnp.arange(0, ROPE_DIM, 2, dtype=jnp.float32) / ROPE_DIM)
    ang = pos[:, None] * inv_freq[None, :]
    return jnp.cos(ang).astype(dtype), jnp.sin(ang).astype(dtype)


def _partial_rope(x, cos, sin):
    half = ROPE_DIM // 2
    x1 = x[..., :half]
    x2 = x[..., half:ROPE_DIM]
    return jnp.concatenate([x1 * cos - x2 * sin, x2 * cos + x1 * sin, x[..., ROPE_DIM:]], axis=-1)


def _moba_attention(q, k, v):
    bsz, nh, seq, hd = q.shape
    s_pad = -(-seq // MOBA_BLOCK) * MOBA_BLOCK
    pad = ((0, 0), (0, 0), (0, s_pad - seq), (0, 0))
    q = jnp.pad(q, pad)
    k = jnp.pad(k, pad)
    v = jnp.pad(v, pad)
    nb = s_pad // MOBA_BLOCK
    kb = k.reshape(bsz, nh, nb, MOBA_BLOCK, hd)
    vb = v.reshape(bsz, nh, nb, MOBA_BLOCK, hd)
    k_mean = jnp.mean(kb.astype(jnp.float32), axis=3)
    gate = jnp.einsum('bhsd,bhnd->bhsn', q.astype(jnp.float32), k_mean)
    q_pos = jnp.arange(s_pad)
    q_blk = q_pos // MOBA_BLOCK
    past = jnp.arange(nb)[None, :] < q_blk[:, None]
    gate = jnp.where(past, gate, -jnp.inf)
    n_top = min(MOBA_TOPK, nb)
    _, top_idx = lax.top_k(gate, n_top)
    top_valid = top_idx < q_blk[:, None]
    own = jnp.broadcast_to(q_blk[:, None], (bsz, nh, s_pad, 1)).astype(top_idx.dtype)
    idx = jnp.concatenate([top_idx, own], axis=-1)
    valid = jnp.concatenate([top_valid, jnp.ones((bsz, nh, s_pad, 1), dtype=bool)], axis=-1)
    n_sel = n_top + 1
    n_chunks = s_pad // MOBA_Q_CHUNK

    def to_chunks(t):
        return jnp.moveaxis(t.reshape(bsz, nh, n_chunks, MOBA_Q_CHUNK, *t.shape[3:]), 2, 0)

    b_ix = jnp.arange(bsz)[:, None, None, None]
    h_ix = jnp.arange(nh)[None, :, None, None]
    offs = jnp.arange(MOBA_BLOCK)
    scale = hd ** -0.5

    def attend(args):
        q_c, idx_c, valid_c, pos_c = args
        k_sel = kb[b_ix, h_ix, idx_c]
        v_sel = vb[b_ix, h_ix, idx_c]
        key_pos = idx_c[..., None] * MOBA_BLOCK + offs
        mask = valid_c[..., None] & (key_pos <= pos_c[None, None, :, None, None])
        logits = jnp.einsum('bhqd,bhqnld->bhqnl', q_c, k_sel, preferred_element_type=jnp.float32) * scale
        logits = jnp.where(mask, logits, -jnp.inf).reshape(bsz, nh, MOBA_Q_CHUNK, n_sel * MOBA_BLOCK)
        p = jax.nn.softmax(logits, axis=-1).reshape(bsz, nh, MOBA_Q_CHUNK, n_sel, MOBA_BLOCK)
        return jnp.einsum('bhqnl,bhqnld->bhqd', p.astype(v_sel.dtype), v_sel)

    out = lax.map(attend, (to_chunks(q), to_chunks(idx), to_chunks(valid), q_pos.reshape(n_chunks, MOBA_Q_CHUNK)))
    out = jnp.moveaxis(out, 0, 2).reshape(bsz, nh, s_pad, hd)
    return out[:, :, :seq]


def _hgrn2(q, f_pre, i, lb):
    bsz, seq, _ = q.shape
    n_chunks = seq // R_CHUNK

    def to_chunks(t, d):
        return t.astype(jnp.float32).reshape(bsz, n_chunks, R_CHUNK, R_HEADS, d).transpose(1, 0, 3, 2, 4)

    qc = to_chunks(jax.nn.silu(q.astype(jnp.float32)), R_KEY_DIM)
    lb_h = lb.reshape(R_HEADS, R_KEY_DIM)[None, None, :, None, :]
    f = lb_h + (1.0 - lb_h) * jax.nn.sigmoid(to_chunks(f_pre, R_KEY_DIM))
    log_f = jnp.log(f)
    kc = 1.0 - f
    vc = to_chunks(i, R_VAL_DIM)
    causal = jnp.tril(jnp.ones((R_CHUNK, R_CHUNK), dtype=bool))[:, :, None]

    def step(state, inp):
        q_t, k_t, v_t, lf_t = inp
        b = jnp.cumsum(lf_t, axis=2)
        diff = b[:, :, :, None, :] - b[:, :, None, :, :]
        decay = jnp.exp(jnp.where(causal, diff, -jnp.inf))
        scores = jnp.einsum('bhtsd,bhsd->bhts', q_t[:, :, :, None, :] * decay, k_t)
        o = jnp.einsum('bhts,bhsv->bhtv', scores, v_t) + jnp.einsum('bhtd,bhdv->bhtv', q_t * jnp.exp(b), state)
        b_last = b[:, :, -1:, :]
        state = jnp.exp(b_last[:, :, 0, :])[..., None] * state + jnp.einsum('bhsd,bhsv->bhdv', k_t * jnp.exp(b_last - b), v_t)
        return state, o

    state0 = jnp.zeros((bsz, R_HEADS, R_KEY_DIM, R_VAL_DIM), jnp.float32)
    _, o = lax.scan(step, state0, (qc, kc, vc, log_f))
    return o.transpose(1, 0, 3, 2, 4).reshape(bsz, seq, R_HEADS, R_VAL_DIM)


def _layer(x, w_in, b_gate, attn_norm_g, q_norm_g, k_norm_g, lb, hgrn_out_norm_g, w_up_a, w_up_r, w_out, mlp_norm_g, w_mlp1, w_mlp2):
    bsz, seq, _ = x.shape
    h = _rmsnorm(x, attn_norm_g)
    proj = h @ w_in
    sizes = [A_WIDTH] * 3 + [R_KWIDTH] * 2 + [R_VWIDTH] * 2 + [D_MODEL] * N_BRANCH
    q_a, k_a, v_a, q_r, f_r, i_r, g_r, gate_a, gate_r = jnp.split(proj, np.cumsum(sizes)[:-1].tolist(), axis=-1)

    def heads(t):
        return t.reshape(bsz, seq, A_HEADS, A_HEAD_DIM)

    cos, sin = _rope_tables(seq, x.dtype)
    q_a = _partial_rope(_rmsnorm(heads(q_a), q_norm_g).transpose(0, 2, 1, 3), cos, sin)
    k_a = _partial_rope(_rmsnorm(heads(k_a), k_norm_g).transpose(0, 2, 1, 3), cos, sin)
    v_a = heads(v_a).transpose(0, 2, 1, 3)
    o_a = _moba_attention(q_a, k_a, v_a).transpose(0, 2, 1, 3).reshape(bsz, seq, A_WIDTH)

    o_r = _hgrn2(q_r, f_r, i_r, lb)
    g_r = jax.nn.sigmoid(g_r.astype(jnp.float32).reshape(bsz, seq, R_HEADS, R_VAL_DIM))
    o_r = (_rmsnorm(o_r, hgrn_out_norm_g.astype(jnp.float32)) * g_r).reshape(bsz, seq, R_VWIDTH).astype(x.dtype)

    merged = jax.nn.sigmoid(gate_a + b_gate[0]) * (o_a @ w_up_a) + jax.nn.sigmoid(gate_r + b_gate[1]) * (o_r @ w_up_r)
    x = x + merged @ w_out
    u = jax.nn.relu(_rmsnorm(x, mlp_norm_g) @ w_mlp1)
    return x + (u * u) @ w_mlp2


def setup_inputs(seed: int = 0) -> dict:
    key = jax.random.key(seed)
    ks = jax.random.split(key, 16)
    f32 = jnp.float32

    def nrm(k, shape, fan_in):
        return jax.random.normal(k, shape, f32) * (fan_in ** -0.5)

    def gain(k, shape):
        return 1.0 + 0.02 * jax.random.normal(k, shape, f32)

    return {
        "x": jax.random.normal(ks[0], (BATCH, SEQ, D_MODEL), f32),
        "w_in": nrm(ks[1], (DEPTH, D_MODEL, D_IN), D_MODEL),
        "b_gate": 0.02 * jax.random.normal(ks[2], (DEPTH, N_BRANCH, D_MODEL), f32),
        "attn_norm_g": gain(ks[3], (DEPTH, D_MODEL)),
        "q_norm_g": gain(ks[4], (DEPTH, A_HEAD_DIM)),
        "k_norm_g": gain(ks[5], (DEPTH, A_HEAD_DIM)),
        "hgrn_lb_logits": 0.5 * jax.random.normal(ks[6], (DEPTH + 1, R_KWIDTH), f32),
        "hgrn_out_norm_g": gain(ks[7], (DEPTH, R_VAL_DIM)),
        "w_up_a": nrm(ks[8], (DEPTH, A_WIDTH, D_MODEL), A_WIDTH),
        "w_up_r": nrm(ks[9], (DEPTH, R_VWIDTH, D_MODEL), R_VWIDTH),
        "w_out": nrm(ks[10], (DEPTH, D_MODEL, D_MODEL), D_MODEL),
        "mlp_norm_g": gain(ks[11], (DEPTH, D_MODEL)),
        "w_mlp1": nrm(ks[12], (DEPTH, D_MODEL, D_FF), D_MODEL),
        "w_mlp2": nrm(ks[13], (DEPTH, D_FF, D_MODEL), D_FF),
    }


def reference(x, w_in, b_gate, attn_norm_g, q_norm_g, k_norm_g, hgrn_lb_logits, hgrn_out_norm_g, w_up_a, w_up_r, w_out, mlp_norm_g, w_mlp1, w_mlp2):
    lb_all = jnp.cumsum(jax.nn.softmax(hgrn_lb_logits.astype(jnp.float32), axis=0), axis=0)
    for l in range(DEPTH):
        x = _layer(x, w_in[l], b_gate[l], attn_norm_g[l], q_norm_g[l], k_norm_g[l], lb_all[l], hgrn_out_norm_g[l], w_up_a[l], w_up_r[l], w_out[l], mlp_norm_g[l], w_mlp1[l], w_mlp2[l])
    return x
```

```cpp
#include <hip/hip_runtime.h>
#include <hip/hip_cooperative_groups.h>
#include <cstdio>
#include <cstdint>
namespace cg = cooperative_groups;
namespace pg8 {
#define PG8_LAS __attribute__((address_space(3)))
typedef unsigned short bf16_t;
typedef short bf16x8 __attribute__((ext_vector_type(8)));
typedef float f32x4 __attribute__((ext_vector_type(4)));
typedef unsigned u32x4 __attribute__((ext_vector_type(4)));
constexpr int BM = 256, BK = 64, HALF = 128, HTB = HALF * BK * 2  , STAGE_BYTES = 8 * HTB, NXCD = 8, WGM = 8;

__host__ __device__ __forceinline__ int lds_byte(int r, int c) { const int st = (r >> 4) * 2 + (c >> 5), rr = r & 15, cc = c & 31, ob = rr * 64 + cc * 2; return st * 1024 + (ob ^ (((ob >> 9) & 1) << 5)); }
__host__ __device__ __forceinline__ void stage_rc(int b, int& R, int& C) { const int st = b / 1024, sb = b % 1024, swz = sb ^ (((sb >> 9) & 1) << 5); R = (st >> 1) * 16 + swz / 64; C = (st & 1) * 32 + (swz % 64) / 2; }
__host__ __device__ __forceinline__ int perm32(int rho) { const int n = rho >> 4, i = rho & 15; return 8 * (i >> 2) + 4 * n + (i & 3); }

struct Unit { int pm, pn; };
struct Gemm { const bf16_t* A; const bf16_t* Bt; int M, N, K; };

struct StaticOrder {
    int nM, nN, nwg, G, c;
    __host__ __device__ void init(int M, int N, int G_, int c_) { nM = M / BM; nN = N / BM; nwg = nM * nN; G = G_; c = c_; }
    __host__ __device__ bool next(int i, Unit& u) const {
        const long L = (long)i * G + c; if (L >= nwg) return false;
        int wgid = (int)L; { const int q = nwg / NXCD, r = nwg % NXCD, xcd = wgid % NXCD, off = wgid / NXCD; wgid = (xcd < r ? xcd * (q + 1) : r * (q + 1) + (xcd - r) * q) + off; }
        const int nig = WGM * nN, gid = wgid / nig, fm = gid * WGM, gsz = (nM - fm) < WGM ? (nM - fm) : WGM;
        u.pm = fm + ((wgid % nig) % gsz); u.pn = (wgid % nig) / gsz; return true;
    }
    __device__ __forceinline__ void a_ready(const Unit&) const {}
    __device__ __forceinline__ void done(const Unit&) const {}
};
__device__ __forceinline__ unsigned cvt_pk_bf16(float lo, float hi) { unsigned r; asm volatile("v_cvt_pk_bf16_f32 %0, %1, %2" : "=v"(r) : "v"(lo), "v"(hi)); return r; }
typedef float f32x2 __attribute__((ext_vector_type(2)));
typedef unsigned u32x2 __attribute__((ext_vector_type(2)));
__device__ __forceinline__ float bf_lo(unsigned w) { return __uint_as_float(w << 16); }
__device__ __forceinline__ float bf_hi(unsigned w) { return __uint_as_float(w & 0xffff0000u); }
__device__ __forceinline__ float sigmoidf_(float x) { return __builtin_amdgcn_rcpf(1.0f + __expf(-x)); }

template <int MODE> struct EpiBf16 {
    static constexpr bool PERM = true, AFTER_DRAIN = false;
    bf16_t* O; int ldc; int split_cols; size_t split_stride; const float* rowscale;
    __device__ __forceinline__ void operator()(const f32x4 (&acc)[2][2][4][2], const Unit& u, int wr, int wc, int fr, int fq) const {
        const int row0 = u.pm * BM + wr * 64 + fr; int colt = u.pn * BM; bf16_t* base = O;
        if (split_cols) { const int t = colt / split_cols; base += (size_t)t * split_stride; colt -= t * split_cols; }
        const int col0 = colt + wc * 32 + 8 * fq;
#pragma unroll
        for (int ai = 0; ai < 2; ++ai)
#pragma unroll
            for (int m = 0; m < 4; ++m) { const int row = row0 + ai * HALF + m * 16; bf16_t* rowp = base + (size_t)row * ldc + col0;
                float rs = 1.f; if (MODE == 1 && rowscale) rs = rowscale[row];
#pragma unroll
                for (int bj = 0; bj < 2; ++bj) { f32x4 v0 = acc[ai][bj][m][0], v1 = acc[ai][bj][m][1];
                    if (MODE == 1) {
#pragma unroll
                        for (int j = 0; j < 4; ++j) { float a = fmaxf(v0[j] * rs, 0.f), b = fmaxf(v1[j] * rs, 0.f); v0[j] = a * a; v1[j] = b * b; } }
                    u32x4 w; w.x = cvt_pk_bf16(v0[0], v0[1]); w.y = cvt_pk_bf16(v0[2], v0[3]); w.z = cvt_pk_bf16(v1[0], v1[1]); w.w = cvt_pk_bf16(v1[2], v1[3]);
                    *(u32x4*)(rowp + bj * HALF) = w; } }
    }
};

struct EpiGate {
    static constexpr bool PERM = true, AFTER_DRAIN = false;
    const bf16_t* gate; size_t gate_split_stride; const float* bias; bf16_t* O; int ldo; int accumulate;
    __device__ __forceinline__ void operator()(const f32x4 (&acc)[2][2][4][2], const Unit& u, int wr, int wc, int fr, int fq) const {
        const int row0 = u.pm * BM + wr * 64 + fr; const int colt = u.pn * BM;
        const bf16_t* gbase = gate + (size_t)(colt >> 10) * gate_split_stride + (colt & 1023);
        const int cw = wc * 32 + 8 * fq;
        f32x4 bv[2][2];
#pragma unroll
        for (int bj = 0; bj < 2; ++bj)
#pragma unroll
            for (int n = 0; n < 2; ++n) bv[bj][n] = *(const f32x4*)(bias + colt + cw + bj * HALF + 4 * n);
#pragma unroll
        for (int ai = 0; ai < 2; ++ai)
#pragma unroll
            for (int m = 0; m < 4; ++m) { const int row = row0 + ai * HALF + m * 16;
#pragma unroll
                for (int bj = 0; bj < 2; ++bj) {
                    const u32x4 gw = *(const u32x4*)(gbase + (size_t)row * 1024 + cw + bj * HALF);
                    bf16_t* op = O + (size_t)row * ldo + colt + cw + bj * HALF;
                    f32x4 g0 = (f32x4){bf_lo(gw.x), bf_hi(gw.x), bf_lo(gw.y), bf_hi(gw.y)} + bv[bj][0];
                    f32x4 g1 = (f32x4){bf_lo(gw.z), bf_hi(gw.z), bf_lo(gw.w), bf_hi(gw.w)} + bv[bj][1];
                    f32x4 v0 = acc[ai][bj][m][0], v1 = acc[ai][bj][m][1];
#pragma unroll
                    for (int j = 0; j < 4; ++j) { v0[j] *= sigmoidf_(g0[j]); v1[j] *= sigmoidf_(g1[j]); }
                    if (accumulate) { const u32x4 pw = *(const u32x4*)op;
                        v0 += (f32x4){bf_lo(pw.x), bf_hi(pw.x), bf_lo(pw.y), bf_hi(pw.y)}; v1 += (f32x4){bf_lo(pw.z), bf_hi(pw.z), bf_lo(pw.w), bf_hi(pw.w)}; }
                    u32x4 w; w.x = cvt_pk_bf16(v0[0], v0[1]); w.y = cvt_pk_bf16(v0[2], v0[3]); w.z = cvt_pk_bf16(v1[0], v1[1]); w.w = cvt_pk_bf16(v1[2], v1[3]);
                    *(u32x4*)op = w; } }
    }
};

struct EpiResid {
    static constexpr bool PERM = false, AFTER_DRAIN = false;
    const float* resid; float* C; int ldc;
    __device__ __forceinline__ void operator()(const f32x4 (&acc)[2][2][4][2], const Unit& u, int wr, int wc, int fr, int fq) const {
        const int row0 = u.pm * BM + wr * 64 + fr, col0 = u.pn * BM + wc * 32 + 4 * fq;
#pragma unroll
        for (int ai = 0; ai < 2; ++ai)
#pragma unroll
            for (int m = 0; m < 4; ++m) { const size_t off = (size_t)(row0 + ai * HALF + m * 16) * ldc + col0;
#pragma unroll
                for (int bj = 0; bj < 2; ++bj)
#pragma unroll
                    for (int n = 0; n < 2; ++n) { const f32x4 r = *(const f32x4*)(resid + off + bj * HALF + n * 16); *(f32x4*)(C + off + bj * HALF + n * 16) = acc[ai][bj][m][n] + r; } }
    }
};
template <class Epi, class Sched, bool STAMP = false>
__device__ __forceinline__ void gemm_phase(PG8_LAS unsigned char* lds, const Gemm g, const Sched& S, const Epi& E, unsigned long long* stamps) {
    const int tid = threadIdx.x, wid = __builtin_amdgcn_readfirstlane(tid >> 6), lane = tid & 63, wr = wid >> 2, wc = wid & 3, fr = lane & 15, fq = lane >> 4;
    const int K = g.K, nt = K / BK;
    int ts_lo = 0, ts_hi = 0, nts = 0; const unsigned long long rt_entry = STAMP ? (unsigned long long)wall_clock64() : 0ull;
#define PG8_STAMP() do { if (STAMP && wid == 0 && nts < 64) { const unsigned long long _c = (unsigned long long)clock64(); \
        ts_lo = (lane == nts) ? (int)(unsigned)_c : ts_lo; ts_hi = (lane == nts) ? (int)(unsigned)(_c >> 32) : ts_hi; ++nts; } } while (0)
    PG8_STAMP();
    unsigned voffA[2], voffB[2];
#pragma unroll
    for (int i = 0; i < 2; ++i) { int R, C; stage_rc(tid * 16 + i * 8192, R, C); const int Rb = Epi::PERM ? ((R & ~31) + perm32(R & 31)) : R;
        voffA[i] = (unsigned)(R * K + C) * 2u; voffB[i] = (unsigned)(Rb * K + C) * 2u; }
    const size_t kstep = (size_t)(BK * 2);
    const size_t hstep = (size_t)HALF * K * 2;
    const size_t tstep = 2 * hstep;
    const unsigned ldsw = (unsigned)wid * 1024u;
    const int aoff = lds_byte(wr * 64 + fr, fq * 8), boff = lds_byte(wc * 32 + fr, fq * 8);
#define PG8_SA(b, h) (((b) * 2 + (h)) * HTB)
#define PG8_SB(b, h) ((4 + (b) * 2 + (h)) * HTB)
#define PG8_STAGE(bufoff, gbase, voff) do { _Pragma("unroll") for (int _i = 0; _i < 2; ++_i) \
        __builtin_amdgcn_global_load_lds((const unsigned*)((const char*)(gbase) + (voff)[_i]), (PG8_LAS unsigned*)(lds + (bufoff) + ldsw + _i * 8192), 16, 0, 0); } while (0)
#define PG8_LDA(dst, b, h) do { _Pragma("unroll") for (int m = 0; m < 4; ++m) _Pragma("unroll") for (int k = 0; k < 2; ++k) dst[m][k] = *(const PG8_LAS bf16x8*)(lds + PG8_SA(b, h) + aoff + m * 2048 + k * 1024); } while (0)
#define PG8_LDB(dst, b, h) do { _Pragma("unroll") for (int n = 0; n < 2; ++n) _Pragma("unroll") for (int k = 0; k < 2; ++k) dst[n][k] = *(const PG8_LAS bf16x8*)(lds + PG8_SB(b, h) + boff + n * 2048 + k * 1024); } while (0)
#define PG8_MMA(ai, bj, At, Bt) do { __builtin_amdgcn_s_setprio(1); _Pragma("unroll") for (int m = 0; m < 4; ++m) _Pragma("unroll") for (int n = 0; n < 2; ++n) _Pragma("unroll") for (int k = 0; k < 2; ++k) \
        acc[ai][bj][m][n] = __builtin_amdgcn_mfma_f32_16x16x32_bf16(Bt[n][k], At[m][k], acc[ai][bj][m][n], 0, 0, 0); __builtin_amdgcn_s_setprio(0); } while (0)
#define PG8_WAIT_V(n) asm volatile("s_waitcnt vmcnt(" #n ")" ::: "memory")
#define PG8_WAIT_L(n) asm volatile("s_waitcnt lgkmcnt(" #n ")" ::: "memory")
#define PG8_BAR __builtin_amdgcn_s_barrier()
#define PG8_SCHED __builtin_amdgcn_sched_barrier(0)
    Unit cur, nxt; int ui = 0;
    if (!S.next(0, cur)) return;
    f32x4 acc[2][2][4][2];
#pragma unroll
    for (int a = 0; a < 2; ++a)
#pragma unroll
        for (int b = 0; b < 2; ++b)
#pragma unroll
            for (int m = 0; m < 4; ++m)
#pragma unroll
                for (int n = 0; n < 2; ++n) acc[a][b][m][n] = (f32x4){0.f, 0.f, 0.f, 0.f};
    bf16x8 At[4][2], B0[2][2], B1[2][2];
    const char* cA = (const char*)g.A + (size_t)cur.pm * tstep; const char* cB = (const char*)g.Bt + (size_t)cur.pn * tstep;
    S.a_ready(cur);
    PG8_STAGE(PG8_SB(0, 0), cB, voffB); PG8_STAGE(PG8_SA(0, 0), cA, voffA); PG8_STAGE(PG8_SB(0, 1), cB + hstep, voffB); PG8_STAGE(PG8_SA(0, 1), cA + hstep, voffA);
    if (wr == 1) PG8_BAR;
    PG8_WAIT_V(4); PG8_BAR;
    PG8_STAGE(PG8_SB(1, 0), cB + kstep, voffB); PG8_STAGE(PG8_SA(1, 0), cA + kstep, voffA); PG8_STAGE(PG8_SB(1, 1), cB + hstep + kstep, voffB);
    PG8_WAIT_V(6); PG8_BAR;
    PG8_STAMP();
    for (;;) {
        const bool has_next = S.next(ui + 1, nxt);
        const char* nA = has_next ? (const char*)g.A + (size_t)nxt.pm * tstep : cA; const char* nB = has_next ? (const char*)g.Bt + (size_t)nxt.pn * tstep : cB;
        for (int t = 0; t < nt; t += 2) {
            const bool last = (t == nt - 2);
            const char* a1 = cA + (size_t)(t + 1) * kstep;
            const char* a2 = last ? nA : cA + (size_t)(t + 2) * kstep; const char* b2 = last ? nB : cB + (size_t)(t + 2) * kstep;
            const char* a3 = a2 + kstep; const char* b3 = b2 + kstep;
            if (last && has_next) S.a_ready(nxt);
            PG8_LDB(B0, 0, 0); PG8_SCHED; PG8_LDA(At, 0, 0); PG8_STAGE(PG8_SA(1, 1), a1 + hstep, voffA);
            PG8_WAIT_L(8); PG8_BAR; PG8_WAIT_L(0); PG8_MMA(0, 0, At, B0); PG8_BAR; PG8_SCHED;
            PG8_LDB(B1, 0, 1); PG8_STAGE(PG8_SB(0, 0), b2, voffB);
            PG8_BAR; PG8_WAIT_L(0); PG8_MMA(0, 1, At, B1); PG8_BAR;
            PG8_LDA(At, 0, 1); PG8_STAGE(PG8_SA(0, 0), a2, voffA);
            PG8_BAR; PG8_WAIT_L(0); PG8_MMA(1, 0, At, B0); PG8_BAR; PG8_SCHED;
            PG8_STAGE(PG8_SB(0, 1), b2 + hstep, voffB);
            PG8_WAIT_V(6); PG8_BAR; PG8_MMA(1, 1, At, B1); PG8_BAR;
            PG8_LDB(B0, 1, 0); PG8_SCHED; PG8_LDA(At, 1, 0); PG8_STAGE(PG8_SA(0, 1), a2 + hstep, voffA);
            PG8_WAIT_L(8); PG8_BAR; PG8_WAIT_L(0); PG8_MMA(0, 0, At, B0); PG8_BAR; PG8_SCHED;
            PG8_LDB(B1, 1, 1); PG8_STAGE(PG8_SB(1, 0), b3, voffB);
            PG8_BAR; PG8_WAIT_L(0); PG8_MMA(0, 1, At, B1); PG8_BAR;
            PG8_LDA(At, 1, 1); PG8_STAGE(PG8_SA(1, 0), a3, voffA);
            PG8_BAR; PG8_WAIT_L(0); PG8_MMA(1, 0, At, B0); PG8_BAR; PG8_SCHED;
            PG8_STAGE(PG8_SB(1, 1), b3 + hstep, voffB);
            PG8_WAIT_V(6); PG8_BAR; PG8_MMA(1, 1, At, B1); PG8_BAR;
        }
        PG8_STAMP();
        if constexpr (!Epi::AFTER_DRAIN) { E(acc, cur, wr, wc, fr, fq); S.done(cur); }
        PG8_STAMP();
        if (!has_next) break;
#pragma unroll
        for (int a = 0; a < 2; ++a)
#pragma unroll
            for (int b = 0; b < 2; ++b)
#pragma unroll
                for (int m = 0; m < 4; ++m)
#pragma unroll
                    for (int n = 0; n < 2; ++n) acc[a][b][m][n] = (f32x4){0.f, 0.f, 0.f, 0.f};
        cur = nxt; cA = nA; cB = nB; ++ui;
    }
    PG8_WAIT_V(0);
    if (wr == 0) PG8_BAR;
    PG8_BAR;
    if constexpr (Epi::AFTER_DRAIN) { E.fused(acc, cur, wr, wc, fr, fq, lds, wid, lane); S.done(cur); }
    PG8_STAMP();
    if (STAMP && wid == 0) { stamps[lane] = lane < nts ? (((unsigned long long)(unsigned)ts_hi << 32) | (unsigned)ts_lo) : 0ull;
        if (lane == 62) stamps[62] = rt_entry; if (lane == 63) stamps[63] = (unsigned long long)wall_clock64(); }
#undef PG8_STAMP
#undef PG8_SA
#undef PG8_SB
#undef PG8_STAGE
#undef PG8_LDA
#undef PG8_LDB
#undef PG8_MMA
#undef PG8_WAIT_V
#undef PG8_WAIT_L
#undef PG8_BAR
#undef PG8_SCHED
}
}
#define LAS __attribute__((address_space(3)))
typedef unsigned short bf16;
typedef float f32x2 __attribute__((ext_vector_type(2)));
typedef float f32x4 __attribute__((ext_vector_type(4)));
typedef float f32x16 __attribute__((ext_vector_type(16)));
typedef short bf16x8 __attribute__((ext_vector_type(8)));
typedef unsigned u32x4 __attribute__((ext_vector_type(4)));
typedef unsigned u32x2 __attribute__((ext_vector_type(2)));
typedef __bf16 nbf16x2 __attribute__((ext_vector_type(2)));

constexpr int NWAVES = 8, NTHR = 512;
constexpr int BATCH = 4, SEQ = 8192, DM = 2048, T = BATCH * SEQ, NH = 8, HD = 128, AW = 1024, DIN = 11264, FF = 8192;
constexpr int NBLK = SEQ / 256, NCH = SEQ / 64;
constexpr float EPS = 1e-6f;
constexpr size_t MiB = (size_t)1 << 20;
constexpr size_t WS_WIN = 0, WS_WUPA = 44 * MiB, WS_WUPR = 48 * MiB, WS_WOUT = 52 * MiB, WS_W1 = 60 * MiB, WS_W2 = 92 * MiB;
constexpr size_t WS_MISC = 124 * MiB;
constexpr size_t WS_LB = WS_MISC, WS_KMH = WS_MISC + 64 * 1024, WS_KML = WS_KMH + 256 * 1024, WS_RSTD = WS_MISC + 768 * 1024, WS_ROPE = WS_MISC + 1 * MiB, WS_DECAY = WS_MISC + 2 * MiB;
constexpr size_t WS_H = 128 * MiB;
constexpr size_t WS_PROJ = 256 * MiB;
constexpr size_t SPLIT = (size_t)T * 1024;
constexpr size_t WS_END = 960 * MiB;
constexpr int LDS_BYTES = 147456;

#define MFMA32(a, b, c) __builtin_amdgcn_mfma_f32_32x32x16_bf16((a), (b), (c), 0, 0, 0)
__device__ __forceinline__ unsigned cvtpk(float lo, float hi) { f32x2 v = {lo, hi}; return __builtin_bit_cast(unsigned, __builtin_convertvector(v, nbf16x2)); }
__device__ __forceinline__ float bflo(unsigned w) { return __uint_as_float(w << 16); }
__device__ __forceinline__ float bfhi(unsigned w) { return __uint_as_float(w & 0xffff0000u); }
__device__ __forceinline__ float bf2f(bf16 b) { return __uint_as_float(((unsigned)b) << 16); }
__device__ __forceinline__ float sigm(float x) { return 1.0f / (1.0f + __expf(-x)); }
__device__ __forceinline__ int crow(int i, int h) { return (i & 3) + 8 * (i >> 2) + 4 * h; }
__device__ __forceinline__ bf16x8 pack8(const f32x16& x, int s) {
    u32x4 p; p.x = cvtpk(x[8 * s], x[8 * s + 1]); p.y = cvtpk(x[8 * s + 2], x[8 * s + 3]); p.z = cvtpk(x[8 * s + 4], x[8 * s + 5]); p.w = cvtpk(x[8 * s + 6], x[8 * s + 7]);
    return __builtin_bit_cast(bf16x8, p);
}
__device__ __forceinline__ float wave_sum(float v) {
#pragma unroll
    for (int o = 1; o < 64; o <<= 1) v += __shfl_xor(v, o);
    return v;
}

struct Args {
    const float* x; const float* w_in; const float* b_gate; const float* attn_g; const float* qn_g; const float* kn_g; const float* lb_logits; const float* hg_g;
    const float* w_up_a; const float* w_up_r; const float* w_out; const float* mlp_g; const float* w_mlp1; const float* w_mlp2;
    float* out; unsigned char* ws; int ph_lo, ph_hi, coop, pad;
};

__device__ __forceinline__ void p0_transpose_item(const float* __restrict__ W, int K, int N, bf16* __restrict__ WT, LAS float* scr, int item, int lane) {
    const int nblk = N / 32, kb = item / nblk, nb = item % nblk, k0 = 64 * kb, n0 = 32 * nb;
#pragma unroll 8
    for (int i = 0; i < 32; ++i) { const int kk = 2 * i + (lane >> 5); scr[kk * 33 + (lane & 31)] = W[(size_t)(k0 + kk) * N + n0 + (lane & 31)]; }
    asm volatile("s_waitcnt lgkmcnt(0)" ::: "memory");
    const int c = lane & 7;
#pragma unroll
    for (int j = 0; j < 4; ++j) { const int n = (lane >> 3) + 8 * j; const LAS float* s = scr + (8 * c) * 33 + n;
        u32x4 o; o.x = cvtpk(s[0 * 33], s[1 * 33]); o.y = cvtpk(s[2 * 33], s[3 * 33]); o.z = cvtpk(s[4 * 33], s[5 * 33]); o.w = cvtpk(s[6 * 33], s[7 * 33]);
        *(u32x4*)(WT + (size_t)(n0 + n) * K + k0 + 8 * c) = o; }
    asm volatile("s_waitcnt lgkmcnt(0)" ::: "memory");
}
__device__ __forceinline__ void rms_row_to_bf16(const float* __restrict__ xrow, const float* __restrict__ g, bf16* __restrict__ orow, int lane) {
    const f32x4* xr = (const f32x4*)xrow + lane; const f32x4* gr = (const f32x4*)g + lane;
    f32x4 v[8]; float s = 0.f;
#pragma unroll
    for (int j = 0; j < 8; ++j) { v[j] = xr[64 * j]; s += (v[j].x * v[j].x + v[j].y * v[j].y) + (v[j].z * v[j].z + v[j].w * v[j].w); }
    const float rstd = rsqrtf(wave_sum(s) * (1.f / DM) + EPS);
    u32x2* o8 = (u32x2*)orow + lane;
#pragma unroll
    for (int j = 0; j < 8; ++j) { const f32x4 gg = gr[64 * j]; u32x2 w; w.x = cvtpk(v[j].x * rstd * gg.x, v[j].y * rstd * gg.y); w.y = cvtpk(v[j].z * rstd * gg.z, v[j].w * rstd * gg.w); o8[64 * j] = w; }
}
__device__ __forceinline__ void p0_prologue(const Args& a, LAS unsigned char* lds, int G, int c) {
    const int tid = threadIdx.x, lane = tid & 63, wave = tid >> 6;
    LAS float* scr = (LAS float*)(lds + wave * 16384);
    const int gw = c * NWAVES + wave, NGW = G * NWAVES;
    unsigned char* ws = a.ws;
    constexpr int I_IN = (DM / 64) * (DIN / 32), I_UP = (AW / 64) * (DM / 32), I_OUT = (DM / 64) * (DM / 32), I_1 = (DM / 64) * (FF / 32), I_2 = (FF / 64) * (DM / 32);
    constexpr int NITEMS = I_IN + 2 * I_UP + I_OUT + I_1 + I_2;
    for (int it = gw; it < NITEMS; it += NGW) {
        int r = it;
        if (r < I_IN) { p0_transpose_item(a.w_in, DM, DIN, (bf16*)(ws + WS_WIN), scr, r, lane); continue; } r -= I_IN;
        if (r < I_UP) { p0_transpose_item(a.w_up_a, AW, DM, (bf16*)(ws + WS_WUPA), scr, r, lane); continue; } r -= I_UP;
        if (r < I_UP) { p0_transpose_item(a.w_up_r, AW, DM, (bf16*)(ws + WS_WUPR), scr, r, lane); continue; } r -= I_UP;
        if (r < I_OUT) { p0_transpose_item(a.w_out, DM, DM, (bf16*)(ws + WS_WOUT), scr, r, lane); continue; } r -= I_OUT;
        if (r < I_1) { p0_transpose_item(a.w_mlp1, DM, FF, (bf16*)(ws + WS_W1), scr, r, lane); continue; } r -= I_1;
        p0_transpose_item(a.w_mlp2, FF, DM, (bf16*)(ws + WS_W2), scr, r, lane);
    }
    bf16* Hb = (bf16*)(ws + WS_H);
    for (int m = gw; m < T; m += NGW) rms_row_to_bf16(a.x + (size_t)m * DM, a.attn_g, Hb + (size_t)m * DM, lane);
    const int gt = c * NTHR + tid, NGT = G * NTHR;
    float* lb = (float*)(ws + WS_LB);
    for (int j = gt; j < 1024; j += NGT) { const float l0 = a.lb_logits[j], l1 = a.lb_logits[1024 + j]; lb[j] = 1.0f / (1.0f + expf(l1 - l0)); }
    float* rope = (float*)(ws + WS_ROPE);
    for (int e = gt; e < SEQ * 16; e += NGT) { const int pos = e >> 4, i = e & 15;
        const float inv_freq = powf(500000.0f, -(float)(2 * i) / 32.0f); const float ang = (float)pos * inv_freq;
        const double rev = (double)ang * 0.15915494309189533577; const double fr = rev - floor(rev); const float r = (float)(fr * 6.283185307179586477);
        rope[pos * 32 + i] = __cosf(r); rope[pos * 32 + 16 + i] = __sinf(r); }
}

__device__ __forceinline__ void p2_qkprep(const Args& a, LAS unsigned char* lds, int G, int c) {
    const int tid = threadIdx.x, lane = tid & 63, wave = tid >> 6, l16 = lane & 15, rg = lane >> 4;
    unsigned char* ws = a.ws;
    bf16* Qp = (bf16*)(ws + WS_PROJ); bf16* Kp = Qp + SPLIT; const bf16* Vp = Qp + 2 * SPLIT;
    bf16* VT = (bf16*)(ws + WS_H + 64 * MiB);
    bf16* KMH = (bf16*)(ws + WS_KMH); bf16* KML = (bf16*)(ws + WS_KML);
    const float* rope = (const float*)(ws + WS_ROPE);
    LAS bf16* vt = (LAS bf16*)lds;
    LAS float* part = (LAS float*)(lds + 69632);
    float gq[8], gk[8];
#pragma unroll
    for (int i = 0; i < 8; ++i) { gq[i] = a.qn_g[8 * l16 + i]; gk[i] = a.kn_g[8 * l16 + i]; }
    for (int u = c; u < BATCH * NH * NBLK; u += G) {
        const int b = u >> 8, h = (u >> 5) & 7, blk = u & 31; const int tok0 = b * SEQ + blk * 256;
#pragma unroll 1
        for (int which = 0; which < 2; ++which) {
            bf16* P = which ? Kp : Qp; float cs[8];
#pragma unroll
            for (int i = 0; i < 8; ++i) cs[i] = 0.f;
#pragma unroll 2
            for (int it = 0; it < 8; ++it) {
                const int row = wave * 32 + it * 4 + rg, pos = blk * 256 + row;
                bf16* p = P + (size_t)(tok0 + row) * 1024 + h * 128 + 8 * l16;
                const u32x4 w = *(const u32x4*)p;
                float v[8] = {bflo(w.x), bfhi(w.x), bflo(w.y), bfhi(w.y), bflo(w.z), bfhi(w.z), bflo(w.w), bfhi(w.w)};
                float ss = 0.f;
#pragma unroll
                for (int i = 0; i < 8; ++i) ss += v[i] * v[i];
                ss += __shfl_xor(ss, 1); ss += __shfl_xor(ss, 2); ss += __shfl_xor(ss, 4); ss += __shfl_xor(ss, 8);
                const float rstd = rsqrtf(ss * (1.f / HD) + EPS);
#pragma unroll
                for (int i = 0; i < 8; ++i) v[i] = v[i] * rstd * (which ? gk[i] : gq[i]);
                float pv[8];
#pragma unroll
                for (int i = 0; i < 8; ++i) pv[i] = __shfl_xor(v[i], 2);
                if (l16 < 4) {
                    const float* rp = rope + pos * 32 + 8 * (l16 & 1);
                    const f32x4 c0 = *(const f32x4*)rp, c1 = *(const f32x4*)(rp + 4), s0 = *(const f32x4*)(rp + 16), s1 = *(const f32x4*)(rp + 20);
                    const float cc[8] = {c0.x, c0.y, c0.z, c0.w, c1.x, c1.y, c1.z, c1.w}, sn[8] = {s0.x, s0.y, s0.z, s0.w, s1.x, s1.y, s1.z, s1.w};
                    const float sgn = (l16 < 2) ? -1.f : 1.f;
#pragma unroll
                    for (int i = 0; i < 8; ++i) v[i] = v[i] * cc[i] + sgn * pv[i] * sn[i];
                }
#pragma unroll
                for (int i = 0; i < 8; ++i) cs[i] += v[i];
                u32x4 o; o.x = cvtpk(v[0], v[1]); o.y = cvtpk(v[2], v[3]); o.z = cvtpk(v[4], v[5]); o.w = cvtpk(v[6], v[7]);
                *(u32x4*)p = o;
            }
            if (which) {
#pragma unroll
                for (int i = 0; i < 8; ++i) { cs[i] += __shfl_xor(cs[i], 16); cs[i] += __shfl_xor(cs[i], 32); }
                if (lane < 16) {
#pragma unroll
                    for (int i = 0; i < 8; ++i) part[wave * 128 + 8 * l16 + i] = cs[i]; }
            }
        }
#pragma unroll 2
        for (int it = 0; it < 8; ++it) {
            const int row = wave * 32 + it * 4 + rg;
            const u32x4 w = *(const u32x4*)(Vp + (size_t)(tok0 + row) * 1024 + h * 128 + 8 * l16);
            const unsigned ww[4] = {w.x, w.y, w.z, w.w};
#pragma unroll
            for (int i = 0; i < 4; ++i) { vt[(8 * l16 + 2 * i) * 264 + row] = (bf16)(ww[i] & 0xffffu); vt[(8 * l16 + 2 * i + 1) * 264 + row] = (bf16)(ww[i] >> 16); }
        }
        __syncthreads();
        if (tid < 128) { float s = 0.f;
#pragma unroll
            for (int w8 = 0; w8 < 8; ++w8) s += part[w8 * 128 + tid];
            s *= (1.f / 256.f);
            const unsigned hi = cvtpk(s, 0.f) & 0xffffu; const float lo = s - bf2f((bf16)hi);
            const size_t o = ((size_t)((b * NH + h) * NBLK + blk)) * 128 + tid;
            KMH[o] = (bf16)hi; KML[o] = (bf16)(cvtpk(lo, 0.f) & 0xffffu); }
#pragma unroll
        for (int k = 0; k < 8; ++k) { const int id = tid + 512 * k, d = id >> 5, cch = id & 31;
            const u32x4 w = *(const LAS u32x4*)((const LAS unsigned char*)vt + d * 528 + cch * 16);
            *(u32x4*)(VT + ((size_t)((b * NH + h) * 128 + d)) * SEQ + blk * 256 + cch * 8) = w; }
        __syncthreads();
    }
}

__device__ __forceinline__ void attn_phase(const Args& a, LAS unsigned char* lds, int G, int c) {
    const int tid = threadIdx.x, lane = tid & 63, wave = tid >> 6, l31 = lane & 31, hh = lane >> 5;
    unsigned char* ws = a.ws;
    const bf16* Qp = (const bf16*)(ws + WS_PROJ); const bf16* Kp = Qp + SPLIT;
    const bf16* VT = (const bf16*)(ws + WS_H + 64 * MiB);
    const bf16* KMH = (const bf16*)(ws + WS_KMH); const bf16* KML = (const bf16*)(ws + WS_KML);
    bf16* OA = (bf16*)(ws + WS_H);
    constexpr int KSTR = 272, VSTR = 136, KBUF = 64 * KSTR, VBUF = 128 * VSTR;
    LAS unsigned char* kb0 = lds; LAS unsigned char* vb0 = lds + 2 * KBUF;
    LAS float* gl = (LAS float*)(lds + 2 * KBUF + 2 * VBUF + wave * 4224);
    const float CS = 0.08838834764831845f * 1.4426950408889634f;
    const float NEG = -1e30f;
    for (int u = c; u < BATCH * NH * NBLK; u += G) {
        const int vc = u & 255, r = u >> 8, g = vc >> 5, bh = vc & 31;
        const int qb = (r == 0) ? 31 - g : (r == 1) ? g : (r == 2) ? 23 - g : 8 + g;
        const int b = bh >> 3, h = bh & 7;
        const size_t tokq = (size_t)b * SEQ + qb * 256 + wave * 32 + l31;
        bf16x8 qf[8];
#pragma unroll
        for (int ks = 0; ks < 8; ++ks) qf[ks] = *(const bf16x8*)(Qp + tokq * 1024 + h * 128 + 16 * ks + 8 * hh);
        unsigned rowmask;
        {
            f32x16 ga;
#pragma unroll
            for (int i = 0; i < 16; ++i) ga[i] = 0.f;
            const bf16* kh = KMH + ((size_t)(bh * NBLK + l31)) * 128 + 8 * hh; const bf16* kl = KML + ((size_t)(bh * NBLK + l31)) * 128 + 8 * hh;
#pragma unroll
            for (int ks = 0; ks < 8; ++ks) { const bf16x8 ah = *(const bf16x8*)(kh + 16 * ks), al = *(const bf16x8*)(kl + 16 * ks); ga = MFMA32(ah, qf[ks], ga); ga = MFMA32(al, qf[ks], ga); }
#pragma unroll
            for (int i = 0; i < 16; ++i) gl[l31 * 33 + crow(i, hh)] = ga[i];
            asm volatile("s_waitcnt lgkmcnt(0)" ::: "memory");
            float v0 = -INFINITY, v1 = -INFINITY, v2 = -INFINITY; int i0 = 32, i1 = 32, i2 = 32;
            for (int j = 0; j < qb; ++j) { const float gv = gl[l31 * 33 + j];
                if (gv > v0) { v2 = v1; i2 = i1; v1 = v0; i1 = i0; v0 = gv; i0 = j; }
                else if (gv > v1) { v2 = v1; i2 = i1; v1 = gv; i1 = j; }
                else if (gv > v2) { v2 = gv; i2 = j; } }
            rowmask = (1u << qb);
            if (i0 < 32) rowmask |= 1u << i0;
            if (i1 < 32) rowmask |= 1u << i1;
            if (i2 < 32) rowmask |= 1u << i2;
            asm volatile("s_waitcnt lgkmcnt(0)" ::: "memory");
        }
        f32x16 ot[4];
#pragma unroll
        for (int dt = 0; dt < 4; ++dt)
#pragma unroll
            for (int i = 0; i < 16; ++i) ot[dt][i] = 0.f;
        float mrow = NEG, lsum = 0.f;
        const int ntile = 4 * (qb + 1);
        const bf16* kg = Kp + ((size_t)b * SEQ) * 1024 + h * 128;
        const bf16* vg = VT + ((size_t)bh * 128) * SEQ;
        u32x4 kr[2], vr[2];
#define ATT_LOAD(tt) do { _Pragma("unroll") for (int k2 = 0; k2 < 2; ++k2) { const int id = tid + 512 * k2; \
            kr[k2] = *(const u32x4*)(kg + (size_t)((tt) * 64 + (id >> 4)) * 1024 + (id & 15) * 8); \
            vr[k2] = *(const u32x4*)(vg + (size_t)(id >> 3) * SEQ + (tt) * 64 + (id & 7) * 8); } } while (0)
#define ATT_WRITE(bufi) do { _Pragma("unroll") for (int k2 = 0; k2 < 2; ++k2) { const int id = tid + 512 * k2; \
            *(LAS u32x4*)(kb0 + (bufi) * KBUF + (id >> 4) * KSTR + (id & 15) * 16) = kr[k2]; \
            LAS u32x2* vd = (LAS u32x2*)(vb0 + (bufi) * VBUF + (id >> 3) * VSTR + (id & 7) * 16); vd[0] = (u32x2){vr[k2].x, vr[k2].y}; vd[1] = (u32x2){vr[k2].z, vr[k2].w}; } } while (0)
        ATT_LOAD(0); ATT_WRITE(0); __syncthreads();
#pragma unroll 1
        for (int tt = 0; tt < ntile; ++tt) {
            const int buf = tt & 1, j = tt >> 2, t4 = tt & 3;
            if (tt + 1 < ntile) ATT_LOAD(tt + 1);
            const LAS unsigned char* kb = kb0 + buf * KBUF; const LAS unsigned char* vb = vb0 + buf * VBUF;
            f32x16 st[2];
#pragma unroll
            for (int kh2 = 0; kh2 < 2; ++kh2) {
#pragma unroll
                for (int i = 0; i < 16; ++i) st[kh2][i] = 0.f;
#pragma unroll
                for (int ks = 0; ks < 8; ++ks) { const bf16x8 kf = *(const LAS bf16x8*)(kb + (32 * kh2 + l31) * KSTR + 32 * ks + 16 * hh); st[kh2] = MFMA32(kf, qf[ks], st[kh2]); }
            }
            const bool diag = (j == qb);
            const bool sel = ((rowmask >> j) & 1u) != 0u;
            const int qloc = wave * 32 + l31;
            float mt = NEG;
#pragma unroll
            for (int kh2 = 0; kh2 < 2; ++kh2)
#pragma unroll
                for (int i = 0; i < 16; ++i) { const int kloc = 64 * t4 + 32 * kh2 + crow(i, hh); const bool ok = sel && (!diag || kloc <= qloc);
                    const float s = ok ? st[kh2][i] : NEG; st[kh2][i] = s; mt = fmaxf(mt, s); }
            mt = fmaxf(mt, __shfl_xor(mt, 32));
            const float mnew = fmaxf(mrow, mt);
            const float alpha = __builtin_amdgcn_exp2f((mrow - mnew) * CS);
            mrow = mnew;
            float ps = 0.f;
#pragma unroll
            for (int kh2 = 0; kh2 < 2; ++kh2)
#pragma unroll
                for (int i = 0; i < 16; ++i) { const float s = st[kh2][i]; const float p = (s > -1e29f) ? __builtin_amdgcn_exp2f((s - mnew) * CS) : 0.f; st[kh2][i] = p; ps += p; }
            lsum = lsum * alpha + ps;
#pragma unroll
            for (int dt = 0; dt < 4; ++dt)
#pragma unroll
                for (int i = 0; i < 16; ++i) ot[dt][i] *= alpha;
#pragma unroll
            for (int kh2 = 0; kh2 < 2; ++kh2)
#pragma unroll
                for (int s2 = 0; s2 < 2; ++s2) { const bf16x8 pf = pack8(st[kh2], s2);
#pragma unroll
                    for (int dt = 0; dt < 4; ++dt) { const LAS unsigned char* vp = vb + (32 * dt + l31) * VSTR + (32 * kh2 + 16 * s2 + 4 * hh) * 2;
                        const u32x2 x0 = *(const LAS u32x2*)vp, x1 = *(const LAS u32x2*)(vp + 16);
                        const u32x4 xv = {x0.x, x0.y, x1.x, x1.y};
                        ot[dt] = MFMA32(__builtin_bit_cast(bf16x8, xv), pf, ot[dt]); } }
            if (tt + 1 < ntile) ATT_WRITE(buf ^ 1);
            __syncthreads();
        }
#undef ATT_LOAD
#undef ATT_WRITE
        lsum += __shfl_xor(lsum, 32);
        const float inv = 1.0f / lsum;
        bf16* op = OA + tokq * 1024 + h * 128;
#pragma unroll
        for (int dt = 0; dt < 4; ++dt)
#pragma unroll
            for (int g4 = 0; g4 < 4; ++g4) { u32x2 w; w.x = cvtpk(ot[dt][4 * g4] * inv, ot[dt][4 * g4 + 1] * inv); w.y = cvtpk(ot[dt][4 * g4 + 2] * inv, ot[dt][4 * g4 + 3] * inv);
                *(u32x2*)(op + 32 * dt + 8 * g4 + 4 * hh) = w; }
    }
}

__device__ __forceinline__ void hgrn_passA(const Args& a, LAS unsigned char* lds, int G, int c) {
    const int tid = threadIdx.x, lane = tid & 63, wave = tid >> 6, l31 = lane & 31, hh = lane >> 5, tg = tid >> 7, d = tid & 127;
    unsigned char* ws = a.ws;
    const bf16* Fp = (const bf16*)(ws + WS_PROJ) + 4 * SPLIT; const bf16* Ip = (const bf16*)(ws + WS_PROJ) + 5 * SPLIT;
    const float* lb = (const float*)(ws + WS_LB); float* decay = (float*)(ws + WS_DECAY); float* DS = a.out;
    LAS unsigned char* KT = lds; LAS unsigned char* VTl = lds + 18432; LAS float* tot = (LAS float*)(lds + 36864);
    for (int u = c; u < BATCH * NH * NCH; u += G) {
        const int bh = u >> 7, cc = u & 127, b = bh >> 3, h = bh & 7; const size_t tok0 = (size_t)b * SEQ + cc * 64 + 16 * tg;
        const float lbv = lb[h * 128 + d];
        float bb[16], kk[16]; float cum = 0.f;
#pragma unroll
        for (int k = 0; k < 16; ++k) { const float fp = bf2f(Fp[(tok0 + k) * 1024 + h * 128 + d]); const float f = lbv + (1.f - lbv) * sigm(fp); cum += __logf(f); bb[k] = cum; kk[k] = 1.f - f; }
        tot[tg * 128 + d] = cum;
        unsigned vw[8];
#pragma unroll
        for (int k = 0; k < 8; ++k) vw[k] = (unsigned)Ip[(tok0 + 2 * k) * 1024 + h * 128 + d] | ((unsigned)Ip[(tok0 + 2 * k + 1) * 1024 + h * 128 + d] << 16);
        __syncthreads();
        const float t0 = tot[d], t1 = tot[128 + d], t2 = tot[256 + d], t3 = tot[384 + d];
        const float off = (tg > 0 ? t0 : 0.f) + (tg > 1 ? t1 : 0.f) + (tg > 2 ? t2 : 0.f), total = (t0 + t1) + (t2 + t3);
        unsigned kw[8];
#pragma unroll
        for (int k = 0; k < 8; ++k) kw[k] = cvtpk(kk[2 * k] * __expf(total - (off + bb[2 * k])), kk[2 * k + 1] * __expf(total - (off + bb[2 * k + 1])));
        *(LAS u32x4*)(KT + d * 144 + tg * 32) = (u32x4){kw[0], kw[1], kw[2], kw[3]}; *(LAS u32x4*)(KT + d * 144 + tg * 32 + 16) = (u32x4){kw[4], kw[5], kw[6], kw[7]};
        *(LAS u32x4*)(VTl + d * 144 + tg * 32) = (u32x4){vw[0], vw[1], vw[2], vw[3]}; *(LAS u32x4*)(VTl + d * 144 + tg * 32 + 16) = (u32x4){vw[4], vw[5], vw[6], vw[7]};
        if (tg == 0) decay[(size_t)u * 128 + d] = __expf(total);
        __syncthreads();
        const int vt = wave >> 1;
#pragma unroll
        for (int dd = 0; dd < 2; ++dd) { const int dtile = 2 * (wave & 1) + dd;
            f32x16 acc;
#pragma unroll
            for (int i = 0; i < 16; ++i) acc[i] = 0.f;
#pragma unroll
            for (int ks = 0; ks < 4; ++ks) { const bf16x8 af = *(const LAS bf16x8*)(VTl + (32 * vt + l31) * 144 + 32 * ks + 16 * hh), bfr = *(const LAS bf16x8*)(KT + (32 * dtile + l31) * 144 + 32 * ks + 16 * hh);
                acc = MFMA32(af, bfr, acc); }
            float* o = DS + ((size_t)u * 128) * 128 + 32 * dtile + l31;
#pragma unroll
            for (int i = 0; i < 16; ++i) o[(size_t)(32 * vt + crow(i, hh)) * 128] = acc[i];
        }
        __syncthreads();
    }
}
__device__ __forceinline__ void hgrn_passB(const Args& a, int G, int c) {
    const float* decay = (const float*)(a.ws + WS_DECAY); float* DS = a.out;
    for (int e = c * NTHR + (int)threadIdx.x; e < 32 * 128 * 32; e += G * NTHR) {
        const int bh = e >> 12, v = (e >> 5) & 127, d4 = e & 31;
        f32x4 S = {0.f, 0.f, 0.f, 0.f};
        float* p = DS + ((size_t)bh * NCH * 128 + v) * 128 + 4 * d4; const float* dc = decay + (size_t)bh * NCH * 128 + 4 * d4;
#pragma unroll 1
        for (int cc = 0; cc < NCH; cc += 8) {
            f32x4 dv[8], de[8];
#pragma unroll
            for (int k = 0; k < 8; ++k) { dv[k] = *(const f32x4*)(p + (size_t)(cc + k) * 16384); de[k] = *(const f32x4*)(dc + (size_t)(cc + k) * 128); }
#pragma unroll
            for (int k = 0; k < 8; ++k) { *(f32x4*)(p + (size_t)(cc + k) * 16384) = S; S = de[k] * S + dv[k]; }
        }
    }
}
__device__ __forceinline__ void hgrn_passC(const Args& a, LAS unsigned char* lds, int G, int c) {
    const int tid = threadIdx.x, lane = tid & 63, wave = tid >> 6, l31 = lane & 31, hh = lane >> 5, tg = tid >> 7, d = tid & 127;
    unsigned char* ws = a.ws;
    const bf16* Qr = (const bf16*)(ws + WS_PROJ) + 3 * SPLIT; const bf16* Fp = Qr + SPLIT; const bf16* Ip = Qr + 2 * SPLIT; const bf16* Gr = Qr + 3 * SPLIT;
    const float* lb = (const float*)(ws + WS_LB); const float* SP = a.out;
    bf16* ORp = (bf16*)(ws + WS_H + 64 * MiB);
    LAS unsigned char* QT = lds; LAS unsigned char* KTl = lds + 17408; LAS unsigned char* QE = lds + 34816; LAS unsigned char* VTl = lds + 52224;
    LAS float* tot = (LAS float*)(lds + 70656); LAS float* ssq = (LAS float*)(lds + 72704);
    for (int u = c; u < BATCH * NH * NCH; u += G) {
        const int bh = u >> 7, cc = u & 127, b = bh >> 3, h = bh & 7; const size_t tokc = (size_t)b * SEQ + cc * 64, tok0 = tokc + 16 * tg;
        const float lbv = lb[h * 128 + d];
        float bb[16], kk[16], qv[16]; float cum = 0.f;
#pragma unroll
        for (int k = 0; k < 16; ++k) { const float fp = bf2f(Fp[(tok0 + k) * 1024 + h * 128 + d]); const float f = lbv + (1.f - lbv) * sigm(fp); cum += __logf(f); bb[k] = cum; kk[k] = 1.f - f;
            const float q = bf2f(Qr[(tok0 + k) * 1024 + h * 128 + d]); qv[k] = q * sigm(q); }
        tot[tg * 128 + d] = cum;
        unsigned vw[8];
#pragma unroll
        for (int k = 0; k < 8; ++k) vw[k] = (unsigned)Ip[(tok0 + 2 * k) * 1024 + h * 128 + d] | ((unsigned)Ip[(tok0 + 2 * k + 1) * 1024 + h * 128 + d] << 16);
        __syncthreads();
        const float t0 = tot[d], t1 = tot[128 + d], t2 = tot[256 + d];
        const float off = (tg > 0 ? t0 : 0.f) + (tg > 1 ? t1 : 0.f) + (tg > 2 ? t2 : 0.f), bref = t0 + t1;
#pragma unroll
        for (int k = 0; k < 16; ++k) { const float bt = off + bb[k]; const int t = 16 * tg + k;
            const float e1 = __expf(fminf(bt - bref, 80.f)), e2 = __expf(fminf(bref - bt, 80.f)), e3 = __expf(bt);
            const unsigned w1 = cvtpk(qv[k] * e1, kk[k] * e2), w2 = cvtpk(qv[k] * e3, 0.f);
            *(LAS bf16*)(QT + t * 272 + 2 * d) = (bf16)(w1 & 0xffffu); *(LAS bf16*)(KTl + t * 272 + 2 * d) = (bf16)(w1 >> 16); *(LAS bf16*)(QE + t * 272 + 2 * d) = (bf16)(w2 & 0xffffu); }
        *(LAS u32x4*)(VTl + d * 144 + tg * 32) = (u32x4){vw[0], vw[1], vw[2], vw[3]}; *(LAS u32x4*)(VTl + d * 144 + tg * 32 + 16) = (u32x4){vw[4], vw[5], vw[6], vw[7]};
        __syncthreads();
        const int tt = wave & 1, vt = wave >> 1;
        f32x16 o;
#pragma unroll
        for (int i = 0; i < 16; ++i) o[i] = 0.f;
#pragma unroll
        for (int sh = 0; sh < 2; ++sh) {
            if (sh <= tt) {
                f32x16 sc;
#pragma unroll
                for (int i = 0; i < 16; ++i) sc[i] = 0.f;
#pragma unroll
                for (int ks = 0; ks < 8; ++ks) { const bf16x8 af = *(const LAS bf16x8*)(KTl + (32 * sh + l31) * 272 + 32 * ks + 16 * hh), bfr = *(const LAS bf16x8*)(QT + (32 * tt + l31) * 272 + 32 * ks + 16 * hh);
                    sc = MFMA32(af, bfr, sc); }
#pragma unroll
                for (int i = 0; i < 16; ++i) { const int s = 32 * sh + crow(i, hh), t = 32 * tt + l31; sc[i] = (s <= t) ? sc[i] : 0.f; }
#pragma unroll
                for (int s2 = 0; s2 < 2; ++s2) { const bf16x8 pf = pack8(sc, s2);
                    const LAS unsigned char* vp = VTl + (32 * vt + l31) * 144 + (32 * sh + 16 * s2 + 4 * hh) * 2;
                    const u32x2 x0 = *(const LAS u32x2*)vp, x1 = *(const LAS u32x2*)(vp + 16); const u32x4 xv = {x0.x, x0.y, x1.x, x1.y};
                    o = MFMA32(__builtin_bit_cast(bf16x8, xv), pf, o); }
            }
        }
        {
            const float* sp = SP + ((size_t)u * 128 + 32 * vt + l31) * 128 + 8 * hh;
#pragma unroll
            for (int ks = 0; ks < 8; ++ks) { const f32x4 s0 = *(const f32x4*)(sp + 16 * ks), s1 = *(const f32x4*)(sp + 16 * ks + 4);
                const u32x4 sw = {cvtpk(s0.x, s0.y), cvtpk(s0.z, s0.w), cvtpk(s1.x, s1.y), cvtpk(s1.z, s1.w)};
                const bf16x8 bfr = *(const LAS bf16x8*)(QE + (32 * tt + l31) * 272 + 32 * ks + 16 * hh);
                o = MFMA32(__builtin_bit_cast(bf16x8, sw), bfr, o); }
        }
        float sq = 0.f;
#pragma unroll
        for (int i = 0; i < 16; ++i) sq += o[i] * o[i];
        sq += __shfl_xor(sq, 32);
        if (hh == 0) ssq[vt * 64 + 32 * tt + l31] = sq;
        __syncthreads();
        const int t = 32 * tt + l31;
        const float rstd = rsqrtf(((ssq[t] + ssq[64 + t]) + (ssq[128 + t] + ssq[192 + t])) * (1.f / 128.f) + EPS);
#pragma unroll
        for (int g4 = 0; g4 < 4; ++g4) { const int v0 = 32 * vt + 8 * g4 + 4 * hh;
            const f32x4 gn = *(const f32x4*)(a.hg_g + v0);
            const u32x2 gw = *(const u32x2*)(Gr + (tokc + t) * 1024 + h * 128 + v0);
            const float r0 = o[4 * g4] * rstd * gn.x * sigm(bflo(gw.x)), r1 = o[4 * g4 + 1] * rstd * gn.y * sigm(bfhi(gw.x)), r2 = o[4 * g4 + 2] * rstd * gn.z * sigm(bflo(gw.y)), r3 = o[4 * g4 + 3] * rstd * gn.w * sigm(bfhi(gw.y));
            *(u32x2*)(ORp + (tokc + t) * 1024 + h * 128 + v0) = (u32x2){cvtpk(r0, r1), cvtpk(r2, r3)}; }
        __syncthreads();
    }
}

__global__ void __launch_bounds__(NTHR, 2) mega(Args a) {
    extern __shared__ __attribute__((aligned(16))) unsigned char lds_raw[];
    LAS unsigned char* lds = (LAS unsigned char*)lds_raw;
    const int G = gridDim.x, c = blockIdx.x;
    unsigned char* ws = a.ws;
    const int lo = a.ph_lo, hi = a.ph_hi;
#define IN(k) (lo <= (k) && (k) < hi)
#define SEAM(k) do { if (a.coop && IN((k) + 1) && IN(k)) { cg::this_grid().sync(); } } while (0)
    bf16* PROJ = (bf16*)(ws + WS_PROJ);
    if (IN(0)) { p0_prologue(a, lds, G, c); __syncthreads(); } SEAM(0);
    if (IN(1)) { pg8::Gemm g{(const bf16*)(ws + WS_H), (const bf16*)(ws + WS_WIN), T, DIN, DM}; pg8::StaticOrder S; S.init(T, DIN, G, c);
        pg8::EpiBf16<0> E{PROJ, 1024, 1024, SPLIT, nullptr}; pg8::gemm_phase<pg8::EpiBf16<0>, pg8::StaticOrder>(lds, g, S, E, nullptr); } SEAM(1);
    if (IN(2)) { p2_qkprep(a, lds, G, c); hgrn_passA(a, lds, G, c); } SEAM(2);
    if (IN(3)) { hgrn_passB(a, G, c); attn_phase(a, lds, G, c); } SEAM(3);
    if (IN(4)) { hgrn_passC(a, lds, G, c);
        pg8::Gemm g{(const bf16*)(ws + WS_H), (const bf16*)(ws + WS_WUPA), T, DM, AW}; pg8::StaticOrder S; S.init(T, DM, G, c);
        pg8::EpiGate E{PROJ + 7 * SPLIT, SPLIT, a.b_gate, PROJ, DM, 0}; pg8::gemm_phase<pg8::EpiGate, pg8::StaticOrder>(lds, g, S, E, nullptr); } SEAM(4);
    if (IN(5)) { pg8::Gemm g{(const bf16*)(ws + WS_H + 64 * MiB), (const bf16*)(ws + WS_WUPR), T, DM, AW}; pg8::StaticOrder S; S.init(T, DM, G, c);
        pg8::EpiGate E{PROJ + 9 * SPLIT, SPLIT, a.b_gate + DM, PROJ, DM, 1}; pg8::gemm_phase<pg8::EpiGate, pg8::StaticOrder>(lds, g, S, E, nullptr); } SEAM(5);
    if (IN(6)) { pg8::Gemm g{PROJ, (const bf16*)(ws + WS_WOUT), T, DM, DM}; pg8::StaticOrder S; S.init(T, DM, G, c);
        pg8::EpiResid E{a.x, a.out, DM}; pg8::gemm_phase<pg8::EpiResid, pg8::StaticOrder>(lds, g, S, E, nullptr); } SEAM(6);
    if (IN(7)) { const int wave = threadIdx.x >> 6, lane = threadIdx.x & 63; bf16* Hb = (bf16*)(ws + WS_H);
        for (int m = c * NWAVES + wave; m < T; m += G * NWAVES) rms_row_to_bf16(a.out + (size_t)m * DM, a.mlp_g, Hb + (size_t)m * DM, lane); } SEAM(7);
    if (IN(8)) { pg8::Gemm g{(const bf16*)(ws + WS_H), (const bf16*)(ws + WS_W1), T, FF, DM}; pg8::StaticOrder S; S.init(T, FF, G, c);
        pg8::EpiBf16<1> E{PROJ + 3 * SPLIT, FF, 0, 0, nullptr}; pg8::gemm_phase<pg8::EpiBf16<1>, pg8::StaticOrder>(lds, g, S, E, nullptr); } SEAM(8);
    if (IN(9)) { pg8::Gemm g{PROJ + 3 * SPLIT, (const bf16*)(ws + WS_W2), T, DM, FF}; pg8::StaticOrder S; S.init(T, DM, G, c);
        pg8::EpiResid E{a.out, a.out, DM}; pg8::gemm_phase<pg8::EpiResid, pg8::StaticOrder>(lds, g, S, E, nullptr); }
#undef IN
#undef SEAM
}

#ifndef MK_SINGLE
#define MK_SINGLE 1
#endif
constexpr int NPHASE = 10;
extern "C" void kernel_launch(void* const* d_in, const int* in_sizes, int n_in, void* d_out, int out_size, void* d_ws, size_t ws_size, hipStream_t stream) {
    static int grid = 0;
    if (grid == 0) {
        if (n_in != 14 || in_sizes[0] != T * DM || out_size != T * DM || ws_size < WS_END) { fprintf(stderr, "kernel_launch: unexpected shapes / workspace (n_in %d in0 %d out %d ws %zu)\n", n_in, n_in > 0 ? in_sizes[0] : -1, out_size, ws_size); grid = -1; return; }
        int dev = 0, cus = 0, per_cu = 0;
        if (hipGetDevice(&dev) != hipSuccess || hipDeviceGetAttribute(&cus, hipDeviceAttributeMultiprocessorCount, dev) != hipSuccess) { grid = -1; return; }
        if (hipFuncSetAttribute((const void*)mega, hipFuncAttributeMaxDynamicSharedMemorySize, LDS_BYTES) != hipSuccess) { fprintf(stderr, "kernel_launch: hipFuncSetAttribute failed\n"); grid = -1; return; }
        if (hipOccupancyMaxActiveBlocksPerMultiprocessor(&per_cu, (const void*)mega, NTHR, LDS_BYTES) != hipSuccess || per_cu < 1) { fprintf(stderr, "kernel_launch: occupancy query says %d\n", per_cu); per_cu = 1; }
        (void)hipGetLastError();
        grid = cus * per_cu;
    }
    if (grid < 0) return;
    Args a{};
    a.x = (const float*)d_in[0]; a.w_in = (const float*)d_in[1]; a.b_gate = (const float*)d_in[2]; a.attn_g = (const float*)d_in[3]; a.qn_g = (const float*)d_in[4]; a.kn_g = (const float*)d_in[5];
    a.lb_logits = (const float*)d_in[6]; a.hg_g = (const float*)d_in[7]; a.w_up_a = (const float*)d_in[8]; a.w_up_r = (const float*)d_in[9]; a.w_out = (const float*)d_in[10]; a.mlp_g = (const float*)d_in[11];
    a.w_mlp1 = (const float*)d_in[12]; a.w_mlp2 = (const float*)d_in[13];
    a.out = (float*)d_out; a.ws = (unsigned char*)d_ws;
#if MK_SINGLE
    a.ph_lo = 0; a.ph_hi = NPHASE; a.coop = 1;
    void* args[] = {&a};
    hipError_t e = hipLaunchCooperativeKernel((const void*)mega, dim3(grid), dim3(NTHR), args, LDS_BYTES, stream);
    if (e != hipSuccess) fprintf(stderr, "kernel_launch: cooperative launch failed: %s (grid %d)\n", hipGetErrorString(e), grid);
#else
    for (int p = 0; p < NPHASE; ++p) { a.ph_lo = p; a.ph_hi = p + 1; a.coop = 0; hipLaunchKernelGGL(mega, dim3(grid), dim3(NTHR), LDS_BYTES, stream, a); }
#endif
}
```

```cpp
#include <hip/hip_runtime.h>
#include <hip/hip_cooperative_groups.h>
#include <cstdio>
#include <cstdint>
namespace cg = cooperative_groups;
namespace pg8 {
#define PG8_LAS __attribute__((address_space(3)))
typedef unsigned short bf16_t;
typedef short bf16x8 __attribute__((ext_vector_type(8)));
typedef float f32x4 __attribute__((ext_vector_type(4)));
typedef unsigned u32x4 __attribute__((ext_vector_type(4)));
constexpr int BM = 256, BK = 64, HALF = 128, HTB = HALF * BK * 2  , STAGE_BYTES = 8 * HTB, NXCD = 8, WGM = 8;

__host__ __device__ __forceinline__ int lds_byte(int r, int c) { const int st = (r >> 4) * 2 + (c >> 5), rr = r & 15, cc = c & 31, ob = rr * 64 + cc * 2; return st * 1024 + (ob ^ (((ob >> 9) & 1) << 5)); }
__host__ __device__ __forceinline__ void stage_rc(int b, int& R, int& C) { const int st = b / 1024, sb = b % 1024, swz = sb ^ (((sb >> 9) & 1) << 5); R = (st >> 1) * 16 + swz / 64; C = (st & 1) * 32 + (swz % 64) / 2; }
__host__ __device__ __forceinline__ int perm32(int rho) { const int n = rho >> 4, i = rho & 15; return 8 * (i >> 2) + 4 * n + (i & 3); }

struct Unit { int pm, pn; };
struct Gemm { const bf16_t* A; const bf16_t* Bt; int M, N, K; };

struct StaticOrder {
    int nM, nN, nwg, G, c;
    __host__ __device__ void init(int M, int N, int G_, int c_) { nM = M / BM; nN = N / BM; nwg = nM * nN; G = G_; c = c_; }
    __host__ __device__ bool next(int i, Unit& u) const {
        const long L = (long)i * G + c; if (L >= nwg) return false;
        int wgid = (int)L; { const int q = nwg / NXCD, r = nwg % NXCD, xcd = wgid % NXCD, off = wgid / NXCD; wgid = (xcd < r ? xcd * (q + 1) : r * (q + 1) + (xcd - r) * q) + off; }
        const int nig = WGM * nN, gid = wgid / nig, fm = gid * WGM, gsz = (nM - fm) < WGM ? (nM - fm) : WGM;
        u.pm = fm + ((wgid % nig) % gsz); u.pn = (wgid % nig) / gsz; return true;
    }
    __device__ __forceinline__ void a_ready(const Unit&) const {}
    __device__ __forceinline__ void done(const Unit&) const {}
};
__device__ __forceinline__ unsigned cvt_pk_bf16(float lo, float hi) { unsigned r; asm volatile("v_cvt_pk_bf16_f32 %0, %1, %2" : "=v"(r) : "v"(lo), "v"(hi)); return r; }
typedef float f32x2 __attribute__((ext_vector_type(2)));
typedef unsigned u32x2 __attribute__((ext_vector_type(2)));
__device__ __forceinline__ float bf_lo(unsigned w) { return __uint_as_float(w << 16); }
__device__ __forceinline__ float bf_hi(unsigned w) { return __uint_as_float(w & 0xffff0000u); }
__device__ __forceinline__ float sigmoidf_(float x) { return __builtin_amdgcn_rcpf(1.0f + __expf(-x)); }

template <int MODE> struct EpiBf16 {
    static constexpr bool PERM = true, AFTER_DRAIN = false;
    bf16_t* O; int ldc; int split_cols; size_t split_stride; const float* rowscale;
    __device__ __forceinline__ void operator()(const f32x4 (&acc)[2][2][4][2], const Unit& u, int wr, int wc, int fr, int fq) const {
        const int row0 = u.pm * BM + wr * 64 + fr; int colt = u.pn * BM; bf16_t* base = O;
        if (split_cols) { const int t = colt / split_cols; base += (size_t)t * split_stride; colt -= t * split_cols; }
        const int col0 = colt + wc * 32 + 8 * fq;
#pragma unroll
        for (int ai = 0; ai < 2; ++ai)
#pragma unroll
            for (int m = 0; m < 4; ++m) { const int row = row0 + ai * HALF + m * 16; bf16_t* rowp = base + (size_t)row * ldc + col0;
                float rs = 1.f; if (MODE == 1 && rowscale) rs = rowscale[row];
#pragma unroll
                for (int bj = 0; bj < 2; ++bj) { f32x4 v0 = acc[ai][bj][m][0], v1 = acc[ai][bj][m][1];
                    if (MODE == 1) {
#pragma unroll
                        for (int j = 0; j < 4; ++j) { float a = fmaxf(v0[j] * rs, 0.f), b = fmaxf(v1[j] * rs, 0.f); v0[j] = a * a; v1[j] = b * b; } }
                    u32x4 w; w.x = cvt_pk_bf16(v0[0], v0[1]); w.y = cvt_pk_bf16(v0[2], v0[3]); w.z = cvt_pk_bf16(v1[0], v1[1]); w.w = cvt_pk_bf16(v1[2], v1[3]);
                    *(u32x4*)(rowp + bj * HALF) = w; } }
    }
};

struct EpiGate {
    static constexpr bool PERM = true, AFTER_DRAIN = false;
    const bf16_t* gate; size_t gate_split_stride; const float* bias; bf16_t* O; int ldo; int accumulate;
    __device__ __forceinline__ void operator()(const f32x4 (&acc)[2][2][4][2], const Unit& u, int wr, int wc, int fr, int fq) const {
        const int row0 = u.pm * BM + wr * 64 + fr; const int colt = u.pn * BM;
        const bf16_t* gbase = gate + (size_t)(colt >> 10) * gate_split_stride + (colt & 1023);
        const int cw = wc * 32 + 8 * fq;
        f32x4 bv[2][2];
#pragma unroll
        for (int bj = 0; bj < 2; ++bj)
#pragma unroll
            for (int n = 0; n < 2; ++n) bv[bj][n] = *(const f32x4*)(bias + colt + cw + bj * HALF + 4 * n);
#pragma unroll
        for (int ai = 0; ai < 2; ++ai)
#pragma unroll
            for (int m = 0; m < 4; ++m) { const int row = row0 + ai * HALF + m * 16;
#pragma unroll
                for (int bj = 0; bj < 2; ++bj) {
                    const u32x4 gw = *(const u32x4*)(gbase + (size_t)row * 1024 + cw + bj * HALF);
                    bf16_t* op = O + (size_t)row * ldo + colt + cw + bj * HALF;
                    f32x4 g0 = (f32x4){bf_lo(gw.x), bf_hi(gw.x), bf_lo(gw.y), bf_hi(gw.y)} + bv[bj][0];
                    f32x4 g1 = (f32x4){bf_lo(gw.z), bf_hi(gw.z), bf_lo(gw.w), bf_hi(gw.w)} + bv[bj][1];
                    f32x4 v0 = acc[ai][bj][m][0], v1 = acc[ai][bj][m][1];
#pragma unroll
                    for (int j = 0; j < 4; ++j) { v0[j] *= sigmoidf_(g0[j]); v1[j] *= sigmoidf_(g1[j]); }
                    if (accumulate) { const u32x4 pw = *(const u32x4*)op;
                        v0 += (f32x4){bf_lo(pw.x), bf_hi(pw.x), bf_lo(pw.y), bf_hi(pw.y)}; v1 += (f32x4){bf_lo(pw.z), bf_hi(pw.z), bf_lo(pw.w), bf_hi(pw.w)}; }
                    u32x4 w; w.x = cvt_pk_bf16(v0[0], v0[1]); w.y = cvt_pk_bf16(v0[2], v0[3]); w.z = cvt_pk_bf16(v1[0], v1[1]); w.w = cvt_pk_bf16(v1[2], v1[3]);
                    *(u32x4*)op = w; } }
    }
};

struct EpiResid {
    static constexpr bool PERM = false, AFTER_DRAIN = false;
    const float* resid; float* C; int ldc;
    __device__ __forceinline__ void operator()(const f32x4 (&acc)[2][2][4][2], const Unit& u, int wr, int wc, int fr, int fq) const {
        const int row0 = u.pm * BM + wr * 64 + fr, col0 = u.pn * BM + wc * 32 + 4 * fq;
#pragma unroll
        for (int ai = 0; ai < 2; ++ai)
#pragma unroll
            for (int m = 0; m < 4; ++m) { const size_t off = (size_t)(row0 + ai * HALF + m * 16) * ldc + col0;
#pragma unroll
                for (int bj = 0; bj < 2; ++bj)
#pragma unroll
                    for (int n = 0; n < 2; ++n) { const f32x4 r = *(const f32x4*)(resid + off + bj * HALF + n * 16); *(f32x4*)(C + off + bj * HALF + n * 16) = acc[ai][bj][m][n] + r; } }
    }
};
template <class Epi, class Sched, bool STAMP = false>
__device__ __forceinline__ void gemm_phase(PG8_LAS unsigned char* lds, const Gemm g, const Sched& S, const Epi& E, unsigned long long* stamps) {
    const int tid = threadIdx.x, wid = __builtin_amdgcn_readfirstlane(tid >> 6), lane = tid & 63, wr = wid >> 2, wc = wid & 3, fr = lane & 15, fq = lane >> 4;
    const int K = g.K, nt = K / BK;
    int ts_lo = 0, ts_hi = 0, nts = 0; const unsigned long long rt_entry = STAMP ? (unsigned long long)wall_clock64() : 0ull;
#define PG8_STAMP() do { if (STAMP && wid == 0 && nts < 64) { const unsigned long long _c = (unsigned long long)clock64(); \
        ts_lo = (lane == nts) ? (int)(unsigned)_c : ts_lo; ts_hi = (lane == nts) ? (int)(unsigned)(_c >> 32) : ts_hi; ++nts; } } while (0)
    PG8_STAMP();
    unsigned voffA[2], voffB[2];
#pragma unroll
    for (int i = 0; i < 2; ++i) { int R, C; stage_rc(tid * 16 + i * 8192, R, C); const int Rb = Epi::PERM ? ((R & ~31) + perm32(R & 31)) : R;
        voffA[i] = (unsigned)(R * K + C) * 2u; voffB[i] = (unsigned)(Rb * K + C) * 2u; }
    const size_t kstep = (size_t)(BK * 2);
    const size_t hstep = (size_t)HALF * K * 2;
    const size_t tstep = 2 * hstep;
    const unsigned ldsw = (unsigned)wid * 1024u;
    const int aoff = lds_byte(wr * 64 + fr, fq * 8), boff = lds_byte(wc * 32 + fr, fq * 8);
#define PG8_SA(b, h) (((b) * 2 + (h)) * HTB)
#define PG8_SB(b, h) ((4 + (b) * 2 + (h)) * HTB)
#define PG8_STAGE(bufoff, gbase, voff) do { _Pragma("unroll") for (int _i = 0; _i < 2; ++_i) \
        __builtin_amdgcn_global_load_lds((const unsigned*)((const char*)(gbase) + (voff)[_i]), (PG8_LAS unsigned*)(lds + (bufoff) + ldsw + _i * 8192), 16, 0, 0); } while (0)
#define PG8_LDA(dst, b, h) do { _Pragma("unroll") for (int m = 0; m < 4; ++m) _Pragma("unroll") for (int k = 0; k < 2; ++k) dst[m][k] = *(const PG8_LAS bf16x8*)(lds + PG8_SA(b, h) + aoff + m * 2048 + k * 1024); } while (0)
#define PG8_LDB(dst, b, h) do { _Pragma("unroll") for (int n = 0; n < 2; ++n) _Pragma("unroll") for (int k = 0; k < 2; ++k) dst[n][k] = *(const PG8_LAS bf16x8*)(lds + PG8_SB(b, h) + boff + n * 2048 + k * 1024); } while (0)
#define PG8_MMA(ai, bj, At, Bt) do { __builtin_amdgcn_s_setprio(1); _Pragma("unroll") for (int m = 0; m < 4; ++m) _Pragma("unroll") for (int n = 0; n < 2; ++n) _Pragma("unroll") for (int k = 0; k < 2; ++k) \
        acc[ai][bj][m][n] = __builtin_amdgcn_mfma_f32_16x16x32_bf16(Bt[n][k], At[m][k], acc[ai][bj][m][n], 0, 0, 0); __builtin_amdgcn_s_setprio(0); } while (0)
#define PG8_WAIT_V(n) asm volatile("s_waitcnt vmcnt(" #n ")" ::: "memory")
#define PG8_WAIT_L(n) asm volatile("s_waitcnt lgkmcnt(" #n ")" ::: "memory")
#define PG8_BAR __builtin_amdgcn_s_barrier()
#define PG8_SCHED __builtin_amdgcn_sched_barrier(0)
    Unit cur, nxt; int ui = 0;
    if (!S.next(0, cur)) return;
    f32x4 acc[2][2][4][2];
#pragma unroll
    for (int a = 0; a < 2; ++a)
#pragma unroll
        for (int b = 0; b < 2; ++b)
#pragma unroll
            for (int m = 0; m < 4; ++m)
#pragma unroll
                for (int n = 0; n < 2; ++n) acc[a][b][m][n] = (f32x4){0.f, 0.f, 0.f, 0.f};
    bf16x8 At[4][2], B0[2][2], B1[2][2];
    const char* cA = (const char*)g.A + (size_t)cur.pm * tstep; const char* cB = (const char*)g.Bt + (size_t)cur.pn * tstep;
    S.a_ready(cur);
    PG8_STAGE(PG8_SB(0, 0), cB, voffB); PG8_STAGE(PG8_SA(0, 0), cA, voffA); PG8_STAGE(PG8_SB(0, 1), cB + hstep, voffB); PG8_STAGE(PG8_SA(0, 1), cA + hstep, voffA);
    if (wr == 1) PG8_BAR;
    PG8_WAIT_V(4); PG8_BAR;
    PG8_STAGE(PG8_SB(1, 0), cB + kstep, voffB); PG8_STAGE(PG8_SA(1, 0), cA + kstep, voffA); PG8_STAGE(PG8_SB(1, 1), cB + hstep + kstep, voffB);
    PG8_WAIT_V(6); PG8_BAR;
    PG8_STAMP();
    for (;;) {
        const bool has_next = S.next(ui + 1, nxt);
        const char* nA = has_next ? (const char*)g.A + (size_t)nxt.pm * tstep : cA; const char* nB = has_next ? (const char*)g.Bt + (size_t)nxt.pn * tstep : cB;
        for (int t = 0; t < nt; t += 2) {
            const bool last = (t == nt - 2);
            const char* a1 = cA + (size_t)(t + 1) * kstep;
            const char* a2 = last ? nA : cA + (size_t)(t + 2) * kstep; const char* b2 = last ? nB : cB + (size_t)(t + 2) * kstep;
            const char* a3 = a2 + kstep; const char* b3 = b2 + kstep;
            if (last && has_next) S.a_ready(nxt);
            PG8_LDB(B0, 0, 0); PG8_SCHED; PG8_LDA(At, 0, 0); PG8_STAGE(PG8_SA(1, 1), a1 + hstep, voffA);
            PG8_WAIT_L(8); PG8_BAR; PG8_WAIT_L(0); PG8_MMA(0, 0, At, B0); PG8_BAR; PG8_SCHED;
            PG8_LDB(B1, 0, 1); PG8_STAGE(PG8_SB(0, 0), b2, voffB);
            PG8_BAR; PG8_WAIT_L(0); PG8_MMA(0, 1, At, B1); PG8_BAR;
            PG8_LDA(At, 0, 1); PG8_STAGE(PG8_SA(0, 0), a2, voffA);
            PG8_BAR; PG8_WAIT_L(0); PG8_MMA(1, 0, At, B0); PG8_BAR; PG8_SCHED;
            PG8_STAGE(PG8_SB(0, 1), b2 + hstep, voffB);
            PG8_WAIT_V(6); PG8_BAR; PG8_MMA(1, 1, At, B1); PG8_BAR;
            PG8_LDB(B0, 1, 0); PG8_SCHED; PG8_LDA(At, 1, 0); PG8_STAGE(PG8_SA(0, 1), a2 + hstep, voffA);
            PG8_WAIT_L(8); PG8_BAR; PG8_WAIT_L(0); PG8_MMA(0, 0, At, B0); PG8_BAR; PG8_SCHED;
            PG8_LDB(B1, 1, 1); PG8_STAGE(PG8_SB(1, 0), b3, voffB);
            PG8_BAR; PG8_WAIT_L(0); PG8_MMA(0, 1, At, B1); PG8_BAR;
            PG8_LDA(At, 1, 1); PG8_STAGE(PG8_SA(1, 0), a3, voffA);
            PG8_BAR; PG8_WAIT_L(0); PG8_MMA(1, 0, At, B0); PG8_BAR; PG8_SCHED;
            PG8_STAGE(PG8_SB(1, 1), b3 + hstep, voffB);
            PG8_WAIT_V(6); PG8_BAR; PG8_MMA(1, 1, At, B1); PG8_BAR;
        }
        PG8_STAMP();
        if constexpr (!Epi::AFTER_DRAIN) { E(acc, cur, wr, wc, fr, fq); S.done(cur); }
        PG8_STAMP();
        if (!has_next) break;
#pragma unroll
        for (int a = 0; a < 2; ++a)
#pragma unroll
            for (int b = 0; b < 2; ++b)
#pragma unroll
                for (int m = 0; m < 4; ++m)
#pragma unroll
                    for (int n = 0; n < 2; ++n) acc[a][b][m][n] = (f32x4){0.f, 0.f, 0.f, 0.f};
        cur = nxt; cA = nA; cB = nB; ++ui;
    }
    PG8_WAIT_V(0);
    if (wr == 0) PG8_BAR;
    PG8_BAR;
    if constexpr (Epi::AFTER_DRAIN) { E.fused(acc, cur, wr, wc, fr, fq, lds, wid, lane); S.done(cur); }
    PG8_STAMP();
    if (STAMP && wid == 0) { stamps[lane] = lane < nts ? (((unsigned long long)(unsigned)ts_hi << 32) | (unsigned)ts_lo) : 0ull;
        if (lane == 62) stamps[62] = rt_entry; if (lane == 63) stamps[63] = (unsigned long long)wall_clock64(); }
#undef PG8_STAMP
#undef PG8_SA
#undef PG8_SB
#undef PG8_STAGE
#undef PG8_LDA
#undef PG8_LDB
#undef PG8_MMA
#undef PG8_WAIT_V
#undef PG8_WAIT_L
#undef PG8_BAR
#undef PG8_SCHED
}
}
#define LAS __attribute__((address_space(3)))
typedef unsigned short bf16;
typedef float f32x2 __attribute__((ext_vector_type(2)));
typedef float f32x4 __attribute__((ext_vector_type(4)));
typedef float f32x16 __attribute__((ext_vector_type(16)));
typedef short bf16x8 __attribute__((ext_vector_type(8)));
typedef unsigned u32x4 __attribute__((ext_vector_type(4)));
typedef unsigned u32x2 __attribute__((ext_vector_type(2)));
typedef __bf16 nbf16x2 __attribute__((ext_vector_type(2)));

constexpr int NWAVES = 8, NTHR = 512;
constexpr int BATCH = 4, SEQ = 8192, DM = 2048, T = BATCH * SEQ, NH = 8, HD = 128, AW = 1024, DIN = 11264, FF = 8192;
constexpr int NBLK = SEQ / 256, NCH = SEQ / 64;
constexpr float EPS = 1e-6f;
constexpr size_t MiB = (size_t)1 << 20;
constexpr size_t WS_WIN = 0, WS_WUPA = 44 * MiB, WS_WUPR = 48 * MiB, WS_WOUT = 52 * MiB, WS_W1 = 60 * MiB, WS_W2 = 92 * MiB;
constexpr size_t WS_MISC = 124 * MiB;
constexpr size_t WS_LB = WS_MISC, WS_KMH = WS_MISC + 64 * 1024, WS_KML = WS_KMH + 256 * 1024, WS_RSTD = WS_MISC + 768 * 1024, WS_ROPE = WS_MISC + 1 * MiB, WS_DECAY = WS_MISC + 2 * MiB;
constexpr size_t WS_H = 128 * MiB;
constexpr size_t WS_PROJ = 256 * MiB;
constexpr size_t SPLIT = (size_t)T * 1024;
constexpr size_t WS_END = 960 * MiB;
constexpr size_t WS_LIST = 960 * MiB, WS_ML = 976 * MiB, WS_GCNT = 984 * MiB;
constexpr int LDS_BYTES = 147456;

#define MFMA32(a, b, c) __builtin_amdgcn_mfma_f32_32x32x16_bf16((a), (b), (c), 0, 0, 0)
__device__ __forceinline__ unsigned cvtpk(float lo, float hi) { f32x2 v = {lo, hi}; return __builtin_bit_cast(unsigned, __builtin_convertvector(v, nbf16x2)); }
__device__ __forceinline__ float bflo(unsigned w) { return __uint_as_float(w << 16); }
__device__ __forceinline__ float bfhi(unsigned w) { return __uint_as_float(w & 0xffff0000u); }
__device__ __forceinline__ float bf2f(bf16 b) { return __uint_as_float(((unsigned)b) << 16); }
__device__ __forceinline__ float sigm(float x) { return 1.0f / (1.0f + __expf(-x)); }
__device__ __forceinline__ int crow(int i, int h) { return (i & 3) + 8 * (i >> 2) + 4 * h; }
__device__ __forceinline__ bf16x8 pack8(const f32x16& x, int s) {
    u32x4 p; p.x = cvtpk(x[8 * s], x[8 * s + 1]); p.y = cvtpk(x[8 * s + 2], x[8 * s + 3]); p.z = cvtpk(x[8 * s + 4], x[8 * s + 5]); p.w = cvtpk(x[8 * s + 6], x[8 * s + 7]);
    return __builtin_bit_cast(bf16x8, p);
}
__device__ __forceinline__ float wave_sum(float v) {
#pragma unroll
    for (int o = 1; o < 64; o <<= 1) v += __shfl_xor(v, o);
    return v;
}

struct Args {
    const float* x; const float* w_in; const float* b_gate; const float* attn_g; const float* qn_g; const float* kn_g; const float* lb_logits; const float* hg_g;
    const float* w_up_a; const float* w_up_r; const float* w_out; const float* mlp_g; const float* w_mlp1; const float* w_mlp2;
    float* out; unsigned char* ws; int ph_lo, ph_hi, coop, pad;
};

__device__ __forceinline__ void p0_transpose_item(const float* __restrict__ W, int K, int N, bf16* __restrict__ WT, LAS float* scr, int item, int lane) {
    const int nblk = N / 32, kb = item / nblk, nb = item % nblk, k0 = 64 * kb, n0 = 32 * nb;
#pragma unroll 8
    for (int i = 0; i < 32; ++i) { const int kk = 2 * i + (lane >> 5); scr[kk * 33 + (lane & 31)] = W[(size_t)(k0 + kk) * N + n0 + (lane & 31)]; }
    asm volatile("s_waitcnt lgkmcnt(0)" ::: "memory");
    const int c = lane & 7;
#pragma unroll
    for (int j = 0; j < 4; ++j) { const int n = (lane >> 3) + 8 * j; const LAS float* s = scr + (8 * c) * 33 + n;
        u32x4 o; o.x = cvtpk(s[0 * 33], s[1 * 33]); o.y = cvtpk(s[2 * 33], s[3 * 33]); o.z = cvtpk(s[4 * 33], s[5 * 33]); o.w = cvtpk(s[6 * 33], s[7 * 33]);
        *(u32x4*)(WT + (size_t)(n0 + n) * K + k0 + 8 * c) = o; }
    asm volatile("s_waitcnt lgkmcnt(0)" ::: "memory");
}
__device__ __forceinline__ void rms_row_to_bf16(const float* __restrict__ xrow, const float* __restrict__ g, bf16* __restrict__ orow, int lane) {
    const f32x4* xr = (const f32x4*)xrow + lane; const f32x4* gr = (const f32x4*)g + lane;
    f32x4 v[8]; float s = 0.f;
#pragma unroll
    for (int j = 0; j < 8; ++j) { v[j] = xr[64 * j]; s += (v[j].x * v[j].x + v[j].y * v[j].y) + (v[j].z * v[j].z + v[j].w * v[j].w); }
    const float rstd = rsqrtf(wave_sum(s) * (1.f / DM) + EPS);
    u32x2* o8 = (u32x2*)orow + lane;
#pragma unroll
    for (int j = 0; j < 8; ++j) { const f32x4 gg = gr[64 * j]; u32x2 w; w.x = cvtpk(v[j].x * rstd * gg.x, v[j].y * rstd * gg.y); w.y = cvtpk(v[j].z * rstd * gg.z, v[j].w * rstd * gg.w); o8[64 * j] = w; }
}
__device__ __forceinline__ void p0_prologue(const Args& a, LAS unsigned char* lds, int G, int c) {
    const int tid = threadIdx.x, lane = tid & 63, wave = tid >> 6;
    LAS float* scr = (LAS float*)(lds + wave * 16384);
    const int gw = c * NWAVES + wave, NGW = G * NWAVES;
    unsigned char* ws = a.ws;
    constexpr int I_IN = (DM / 64) * (DIN / 32), I_UP = (AW / 64) * (DM / 32), I_OUT = (DM / 64) * (DM / 32), I_1 = (DM / 64) * (FF / 32), I_2 = (FF / 64) * (DM / 32);
    constexpr int NITEMS = I_IN + 2 * I_UP + I_OUT + I_1 + I_2;
    for (int it = gw; it < NITEMS; it += NGW) {
        int r = it;
        if (r < I_IN) { p0_transpose_item(a.w_in, DM, DIN, (bf16*)(ws + WS_WIN), scr, r, lane); continue; } r -= I_IN;
        if (r < I_UP) { p0_transpose_item(a.w_up_a, AW, DM, (bf16*)(ws + WS_WUPA), scr, r, lane); continue; } r -= I_UP;
        if (r < I_UP) { p0_transpose_item(a.w_up_r, AW, DM, (bf16*)(ws + WS_WUPR), scr, r, lane); continue; } r -= I_UP;
        if (r < I_OUT) { p0_transpose_item(a.w_out, DM, DM, (bf16*)(ws + WS_WOUT), scr, r, lane); continue; } r -= I_OUT;
        if (r < I_1) { p0_transpose_item(a.w_mlp1, DM, FF, (bf16*)(ws + WS_W1), scr, r, lane); continue; } r -= I_1;
        p0_transpose_item(a.w_mlp2, FF, DM, (bf16*)(ws + WS_W2), scr, r, lane);
    }
    bf16* Hb = (bf16*)(ws + WS_H);
    for (int m = gw; m < T; m += NGW) rms_row_to_bf16(a.x + (size_t)m * DM, a.attn_g, Hb + (size_t)m * DM, lane);
    const int gt = c * NTHR + tid, NGT = G * NTHR;
    float* lb = (float*)(ws + WS_LB);
    for (int j = gt; j < 1024; j += NGT) { const float l0 = a.lb_logits[j], l1 = a.lb_logits[1024 + j]; lb[j] = 1.0f / (1.0f + expf(l1 - l0)); }
    unsigned* gcnt = (unsigned*)(ws + WS_GCNT);
    for (int j = gt; j < 1024; j += NGT) gcnt[j] = 0u;
    float* rope = (float*)(ws + WS_ROPE);
    for (int e = gt; e < SEQ * 16; e += NGT) { const int pos = e >> 4, i = e & 15;
        const float inv_freq = powf(500000.0f, -(float)(2 * i) / 32.0f); const float ang = (float)pos * inv_freq;
        const double rev = (double)ang * 0.15915494309189533577; const double fr = rev - floor(rev); const float r = (float)(fr * 6.283185307179586477);
        rope[pos * 32 + i] = __cosf(r); rope[pos * 32 + 16 + i] = __sinf(r); }
}

__device__ __forceinline__ void p2_qkprep(const Args& a, LAS unsigned char* lds, int G, int c) {
    const int tid = threadIdx.x, lane = tid & 63, wave = tid >> 6, l16 = lane & 15, rg = lane >> 4;
    unsigned char* ws = a.ws;
    bf16* Qp = (bf16*)(ws + WS_PROJ); bf16* Kp = Qp + SPLIT; const bf16* Vp = Qp + 2 * SPLIT;
    bf16* VT = (bf16*)(ws + WS_H + 64 * MiB);
    bf16* KMH = (bf16*)(ws + WS_KMH); bf16* KML = (bf16*)(ws + WS_KML);
    const float* rope = (const float*)(ws + WS_ROPE);
    LAS bf16* vt = (LAS bf16*)lds;
    LAS float* part = (LAS float*)(lds + 69632);
    float gq[8], gk[8];
#pragma unroll
    for (int i = 0; i < 8; ++i) { gq[i] = a.qn_g[8 * l16 + i]; gk[i] = a.kn_g[8 * l16 + i]; }
    for (int u = c; u < BATCH * NH * NBLK; u += G) {
        const int b = u >> 8, h = (u >> 5) & 7, blk = u & 31; const int tok0 = b * SEQ + blk * 256;
#pragma unroll 1
        for (int which = 0; which < 2; ++which) {
            bf16* P = which ? Kp : Qp; float cs[8];
#pragma unroll
            for (int i = 0; i < 8; ++i) cs[i] = 0.f;
#pragma unroll 2
            for (int it = 0; it < 8; ++it) {
                const int row = wave * 32 + it * 4 + rg, pos = blk * 256 + row;
                bf16* p = P + (size_t)(tok0 + row) * 1024 + h * 128 + 8 * l16;
                const u32x4 w = *(const u32x4*)p;
                float v[8] = {bflo(w.x), bfhi(w.x), bflo(w.y), bfhi(w.y), bflo(w.z), bfhi(w.z), bflo(w.w), bfhi(w.w)};
                float ss = 0.f;
#pragma unroll
                for (int i = 0; i < 8; ++i) ss += v[i] * v[i];
                ss += __shfl_xor(ss, 1); ss += __shfl_xor(ss, 2); ss += __shfl_xor(ss, 4); ss += __shfl_xor(ss, 8);
                const float rstd = rsqrtf(ss * (1.f / HD) + EPS);
#pragma unroll
                for (int i = 0; i < 8; ++i) v[i] = v[i] * rstd * (which ? gk[i] : gq[i]);
                float pv[8];
#pragma unroll
                for (int i = 0; i < 8; ++i) pv[i] = __shfl_xor(v[i], 2);
                if (l16 < 4) {
                    const float* rp = rope + pos * 32 + 8 * (l16 & 1);
                    const f32x4 c0 = *(const f32x4*)rp, c1 = *(const f32x4*)(rp + 4), s0 = *(const f32x4*)(rp + 16), s1 = *(const f32x4*)(rp + 20);
                    const float cc[8] = {c0.x, c0.y, c0.z, c0.w, c1.x, c1.y, c1.z, c1.w}, sn[8] = {s0.x, s0.y, s0.z, s0.w, s1.x, s1.y, s1.z, s1.w};
                    const float sgn = (l16 < 2) ? -1.f : 1.f;
#pragma unroll
                    for (int i = 0; i < 8; ++i) v[i] = v[i] * cc[i] + sgn * pv[i] * sn[i];
                }
#pragma unroll
                for (int i = 0; i < 8; ++i) cs[i] += v[i];
                u32x4 o; o.x = cvtpk(v[0], v[1]); o.y = cvtpk(v[2], v[3]); o.z = cvtpk(v[4], v[5]); o.w = cvtpk(v[6], v[7]);
                *(u32x4*)p = o;
            }
            if (which) {
#pragma unroll
                for (int i = 0; i < 8; ++i) { cs[i] += __shfl_xor(cs[i], 16); cs[i] += __shfl_xor(cs[i], 32); }
                if (lane < 16) {
#pragma unroll
                    for (int i = 0; i < 8; ++i) part[wave * 128 + 8 * l16 + i] = cs[i]; }
            }
        }
#pragma unroll 2
        for (int it = 0; it < 8; ++it) {
            const int row = wave * 32 + it * 4 + rg;
            const u32x4 w = *(const u32x4*)(Vp + (size_t)(tok0 + row) * 1024 + h * 128 + 8 * l16);
            const unsigned ww[4] = {w.x, w.y, w.z, w.w};
#pragma unroll
            for (int i = 0; i < 4; ++i) { vt[(8 * l16 + 2 * i) * 264 + row] = (bf16)(ww[i] & 0xffffu); vt[(8 * l16 + 2 * i + 1) * 264 + row] = (bf16)(ww[i] >> 16); }
        }
        __syncthreads();
        if (tid < 128) { float s = 0.f;
#pragma unroll
            for (int w8 = 0; w8 < 8; ++w8) s += part[w8 * 128 + tid];
            s *= (1.f / 256.f);
            const unsigned hi = cvtpk(s, 0.f) & 0xffffu; const float lo = s - bf2f((bf16)hi);
            const size_t o = ((size_t)((b * NH + h) * NBLK + blk)) * 128 + tid;
            KMH[o] = (bf16)hi; KML[o] = (bf16)(cvtpk(lo, 0.f) & 0xffffu); }
#pragma unroll
        for (int k = 0; k < 8; ++k) { const int id = tid + 512 * k, d = id >> 5, cch = id & 31;
            const u32x4 w = *(const LAS u32x4*)((const LAS unsigned char*)vt + d * 528 + cch * 16);
            *(u32x4*)(VT + ((size_t)((b * NH + h) * 128 + d)) * SEQ + blk * 256 + cch * 8) = w; }
        __syncthreads();
    }
}

__device__ __forceinline__ void attn_phase(const Args& a, LAS unsigned char* lds, int G, int c) {
    const int tid = threadIdx.x, lane = tid & 63, wave = tid >> 6, l31 = lane & 31, hh = lane >> 5;
    unsigned char* ws = a.ws;
    const bf16* Qp = (const bf16*)(ws + WS_PROJ); const bf16* Kp = Qp + SPLIT;
    const bf16* VT = (const bf16*)(ws + WS_H + 64 * MiB);
    const bf16* KMH = (const bf16*)(ws + WS_KMH); const bf16* KML = (const bf16*)(ws + WS_KML);
    bf16* OA = (bf16*)(ws + WS_H);
    constexpr int KSTR = 272, VSTR = 136, KBUF = 64 * KSTR, VBUF = 128 * VSTR;
    LAS unsigned char* kb0 = lds; LAS unsigned char* vb0 = lds + 2 * KBUF;
    LAS float* gl = (LAS float*)(lds + 2 * KBUF + 2 * VBUF + wave * 4224);
    const float CS = 0.08838834764831845f * 1.4426950408889634f;
    const float NEG = -1e30f;
    for (int u = c; u < BATCH * NH * NBLK; u += G) {
        const int vc = u & 255, r = u >> 8, g = vc >> 5, bh = vc & 31;
        const int qb = (r == 0) ? 31 - g : (r == 1) ? g : (r == 2) ? 23 - g : 8 + g;
        const int b = bh >> 3, h = bh & 7;
        const size_t tokq = (size_t)b * SEQ + qb * 256 + wave * 32 + l31;
        bf16x8 qf[8];
#pragma unroll
        for (int ks = 0; ks < 8; ++ks) qf[ks] = *(const bf16x8*)(Qp + tokq * 1024 + h * 128 + 16 * ks + 8 * hh);
        unsigned rowmask;
        {
            f32x16 ga;
#pragma unroll
            for (int i = 0; i < 16; ++i) ga[i] = 0.f;
            const bf16* kh = KMH + ((size_t)(bh * NBLK + l31)) * 128 + 8 * hh; const bf16* kl = KML + ((size_t)(bh * NBLK + l31)) * 128 + 8 * hh;
#pragma unroll
            for (int ks = 0; ks < 8; ++ks) { const bf16x8 ah = *(const bf16x8*)(kh + 16 * ks), al = *(const bf16x8*)(kl + 16 * ks); ga = MFMA32(ah, qf[ks], ga); ga = MFMA32(al, qf[ks], ga); }
#pragma unroll
            for (int i = 0; i < 16; ++i) gl[l31 * 33 + crow(i, hh)] = ga[i];
            asm volatile("s_waitcnt lgkmcnt(0)" ::: "memory");
            float v0 = -INFINITY, v1 = -INFINITY, v2 = -INFINITY; int i0 = 32, i1 = 32, i2 = 32;
            for (int j = 0; j < qb; ++j) { const float gv = gl[l31 * 33 + j];
                if (gv > v0) { v2 = v1; i2 = i1; v1 = v0; i1 = i0; v0 = gv; i0 = j; }
                else if (gv > v1) { v2 = v1; i2 = i1; v1 = gv; i1 = j; }
                else if (gv > v2) { v2 = gv; i2 = j; } }
            rowmask = (1u << qb);
            if (i0 < 32) rowmask |= 1u << i0;
            if (i1 < 32) rowmask |= 1u << i1;
            if (i2 < 32) rowmask |= 1u << i2;
            asm volatile("s_waitcnt lgkmcnt(0)" ::: "memory");
        }
        f32x16 ot[4];
#pragma unroll
        for (int dt = 0; dt < 4; ++dt)
#pragma unroll
            for (int i = 0; i < 16; ++i) ot[dt][i] = 0.f;
        float mrow = NEG, lsum = 0.f;
        const int ntile = 4 * (qb + 1);
        const bf16* kg = Kp + ((size_t)b * SEQ) * 1024 + h * 128;
        const bf16* vg = VT + ((size_t)bh * 128) * SEQ;
        u32x4 kr[2], vr[2];
#define ATT_LOAD(tt) do { _Pragma("unroll") for (int k2 = 0; k2 < 2; ++k2) { const int id = tid + 512 * k2; \
            kr[k2] = *(const u32x4*)(kg + (size_t)((tt) * 64 + (id >> 4)) * 1024 + (id & 15) * 8); \
            vr[k2] = *(const u32x4*)(vg + (size_t)(id >> 3) * SEQ + (tt) * 64 + (id & 7) * 8); } } while (0)
#define ATT_WRITE(bufi) do { _Pragma("unroll") for (int k2 = 0; k2 < 2; ++k2) { const int id = tid + 512 * k2; \
            *(LAS u32x4*)(kb0 + (bufi) * KBUF + (id >> 4) * KSTR + (id & 15) * 16) = kr[k2]; \
            LAS u32x2* vd = (LAS u32x2*)(vb0 + (bufi) * VBUF + (id >> 3) * VSTR + (id & 7) * 16); vd[0] = (u32x2){vr[k2].x, vr[k2].y}; vd[1] = (u32x2){vr[k2].z, vr[k2].w}; } } while (0)
        ATT_LOAD(0); ATT_WRITE(0); __syncthreads();
#pragma unroll 1
        for (int tt = 0; tt < ntile; ++tt) {
            const int buf = tt & 1, j = tt >> 2, t4 = tt & 3;
            if (tt + 1 < ntile) ATT_LOAD(tt + 1);
            const LAS unsigned char* kb = kb0 + buf * KBUF; const LAS unsigned char* vb = vb0 + buf * VBUF;
            f32x16 st[2];
#pragma unroll
            for (int kh2 = 0; kh2 < 2; ++kh2) {
#pragma unroll
                for (int i = 0; i < 16; ++i) st[kh2][i] = 0.f;
#pragma unroll
                for (int ks = 0; ks < 8; ++ks) { const bf16x8 kf = *(const LAS bf16x8*)(kb + (32 * kh2 + l31) * KSTR + 32 * ks + 16 * hh); st[kh2] = MFMA32(kf, qf[ks], st[kh2]); }
            }
            const bool diag = (j == qb);
            const bool sel = ((rowmask >> j) & 1u) != 0u;
            const int qloc = wave * 32 + l31;
            float mt = NEG;
#pragma unroll
            for (int kh2 = 0; kh2 < 2; ++kh2)
#pragma unroll
                for (int i = 0; i < 16; ++i) { const int kloc = 64 * t4 + 32 * kh2 + crow(i, hh); const bool ok = sel && (!diag || kloc <= qloc);
                    const float s = ok ? st[kh2][i] : NEG; st[kh2][i] = s; mt = fmaxf(mt, s); }
            mt = fmaxf(mt, __shfl_xor(mt, 32));
            const float mnew = fmaxf(mrow, mt);
            const float alpha = __builtin_amdgcn_exp2f((mrow - mnew) * CS);
            mrow = mnew;
            float ps = 0.f;
#pragma unroll
            for (int kh2 = 0; kh2 < 2; ++kh2)
#pragma unroll
                for (int i = 0; i < 16; ++i) { const float s = st[kh2][i]; const float p = (s > -1e29f) ? __builtin_amdgcn_exp2f((s - mnew) * CS) : 0.f; st[kh2][i] = p; ps += p; }
            lsum = lsum * alpha + ps;
#pragma unroll
            for (int dt = 0; dt < 4; ++dt)
#pragma unroll
                for (int i = 0; i < 16; ++i) ot[dt][i] *= alpha;
#pragma unroll
            for (int kh2 = 0; kh2 < 2; ++kh2)
#pragma unroll
                for (int s2 = 0; s2 < 2; ++s2) { const bf16x8 pf = pack8(st[kh2], s2);
#pragma unroll
                    for (int dt = 0; dt < 4; ++dt) { const LAS unsigned char* vp = vb + (32 * dt + l31) * VSTR + (32 * kh2 + 16 * s2 + 4 * hh) * 2;
                        const u32x2 x0 = *(const LAS u32x2*)vp, x1 = *(const LAS u32x2*)(vp + 16);
                        const u32x4 xv = {x0.x, x0.y, x1.x, x1.y};
                        ot[dt] = MFMA32(__builtin_bit_cast(bf16x8, xv), pf, ot[dt]); } }
            if (tt + 1 < ntile) ATT_WRITE(buf ^ 1);
            __syncthreads();
        }
#undef ATT_LOAD
#undef ATT_WRITE
        lsum += __shfl_xor(lsum, 32);
        const float inv = 1.0f / lsum;
        bf16* op = OA + tokq * 1024 + h * 128;
#pragma unroll
        for (int dt = 0; dt < 4; ++dt)
#pragma unroll
            for (int g4 = 0; g4 < 4; ++g4) { u32x2 w; w.x = cvtpk(ot[dt][4 * g4] * inv, ot[dt][4 * g4 + 1] * inv); w.y = cvtpk(ot[dt][4 * g4 + 2] * inv, ot[dt][4 * g4 + 3] * inv);
                *(u32x2*)(op + 32 * dt + 8 * g4 + 4 * hh) = w; }
    }
}

constexpr int AT_KSTR = 272, AT_VSTR = 136, AT_KBUF = 64 * AT_KSTR, AT_VBUF = 128 * AT_VSTR;
#define AT_CS (0.08838834764831845f * 1.4426950408889634f)
#define AT_NEG (-1e30f)

template <bool DIAG> __device__ __forceinline__ void att_tile(const LAS unsigned char* kb, const LAS unsigned char* vb, const bf16x8 (&qf)[8], f32x16 (&ot)[4], float& mrow, float& lsum, int t4, int qloc, int l31, int hh) {
    f32x16 st[2];
#pragma unroll
    for (int kh2 = 0; kh2 < 2; ++kh2) {
#pragma unroll
        for (int i = 0; i < 16; ++i) st[kh2][i] = 0.f;
#pragma unroll
        for (int ks = 0; ks < 8; ++ks) { const bf16x8 kf = *(const LAS bf16x8*)(kb + (32 * kh2 + l31) * AT_KSTR + 32 * ks + 16 * hh); st[kh2] = MFMA32(kf, qf[ks], st[kh2]); }
    }
    float mt = AT_NEG;
#pragma unroll
    for (int kh2 = 0; kh2 < 2; ++kh2)
#pragma unroll
        for (int i = 0; i < 16; ++i) { if (DIAG) { const int kloc = 64 * t4 + 32 * kh2 + crow(i, hh); st[kh2][i] = (kloc <= qloc) ? st[kh2][i] : AT_NEG; } mt = fmaxf(mt, st[kh2][i]); }
    mt = fmaxf(mt, __shfl_xor(mt, 32));
    const float mnew = fmaxf(mrow, mt);
    const float alpha = __builtin_amdgcn_exp2f((mrow - mnew) * AT_CS);
    const bool chg = mnew > mrow;
    mrow = mnew;
    const float mc = mnew * AT_CS;
    float ps = 0.f;
#pragma unroll
    for (int kh2 = 0; kh2 < 2; ++kh2)
#pragma unroll
        for (int i = 0; i < 16; ++i) { const float s = st[kh2][i]; float p = __builtin_amdgcn_exp2f(s * AT_CS - mc); if (DIAG) p = (s > -1e29f) ? p : 0.f; st[kh2][i] = p; ps += p; }
    lsum = lsum * alpha + ps;
    if (__builtin_amdgcn_ballot_w64(chg) != 0ull) {
#pragma unroll
        for (int dt = 0; dt < 4; ++dt)
#pragma unroll
            for (int i = 0; i < 16; ++i) ot[dt][i] *= alpha;
    }
#pragma unroll
    for (int kh2 = 0; kh2 < 2; ++kh2)
#pragma unroll
        for (int s2 = 0; s2 < 2; ++s2) { const bf16x8 pf = pack8(st[kh2], s2);
#pragma unroll
            for (int dt = 0; dt < 4; ++dt) { const LAS unsigned char* vp = vb + (32 * dt + l31) * AT_VSTR + (32 * kh2 + 16 * s2 + 4 * hh) * 2;
                const u32x2 x0 = *(const LAS u32x2*)vp, x1 = *(const LAS u32x2*)(vp + 16);
                const u32x4 xv = {x0.x, x0.y, x1.x, x1.y};
                ot[dt] = MFMA32(__builtin_bit_cast(bf16x8, xv), pf, ot[dt]); } }
}
#define AT_LOAD(tt) do { _Pragma("unroll") for (int k2 = 0; k2 < 2; ++k2) { const int id = tid + 512 * k2; \
        kr[k2] = *(const u32x4*)(kg + (size_t)((tt) * 64 + (id >> 4)) * 1024 + (id & 15) * 8); \
        vr[k2] = *(const u32x4*)(vg + (size_t)(id >> 3) * SEQ + (tt) * 64 + (id & 7) * 8); } } while (0)
#define AT_WRITE(bufi) do { _Pragma("unroll") for (int k2 = 0; k2 < 2; ++k2) { const int id = tid + 512 * k2; \
        *(LAS u32x4*)(kb0 + (bufi) * AT_KBUF + (id >> 4) * AT_KSTR + (id & 15) * 16) = kr[k2]; \
        LAS u32x2* vd = (LAS u32x2*)(vb0 + (bufi) * AT_VBUF + (id >> 3) * AT_VSTR + (id & 7) * 16); vd[0] = (u32x2){vr[k2].x, vr[k2].y}; vd[1] = (u32x2){vr[k2].z, vr[k2].w}; } } while (0)

__device__ __forceinline__ void sel_phase(const Args& a, LAS unsigned char* lds, int G, int c) {
    const int tid = threadIdx.x, lane = tid & 63, wave = tid >> 6, l31 = lane & 31, hh = lane >> 5;
    unsigned char* ws = a.ws;
    const bf16* Qp = (const bf16*)(ws + WS_PROJ);
    const bf16* KMH = (const bf16*)(ws + WS_KMH); const bf16* KML = (const bf16*)(ws + WS_KML);
    unsigned short* LIST = (unsigned short*)(ws + WS_LIST); f32x2* ML = (f32x2*)(ws + WS_ML); unsigned* GCNT = (unsigned*)(ws + WS_GCNT);
    LAS float* gl = (LAS float*)(lds + wave * 4224);
    LAS unsigned* lcnt = (LAS unsigned*)(lds + 36864); LAS unsigned* lbase = lcnt + 32;
    for (int u = c; u < BATCH * NH * NBLK; u += G) {
        const int bh = u >> 5, qb = u & 31, b = bh >> 3, h = bh & 7;
        const int q = qb * 256 + wave * 32 + l31;
        if (tid < 32) lcnt[tid] = 0u;
        int i0 = 32, i1 = 32, i2 = 32;
        if (qb > 0) {
            bf16x8 qf[8];
#pragma unroll
            for (int ks = 0; ks < 8; ++ks) qf[ks] = *(const bf16x8*)(Qp + ((size_t)b * SEQ + q) * 1024 + h * 128 + 16 * ks + 8 * hh);
            f32x16 ga;
#pragma unroll
            for (int i = 0; i < 16; ++i) ga[i] = 0.f;
            const bf16* kh = KMH + ((size_t)(bh * NBLK + l31)) * 128 + 8 * hh; const bf16* kl = KML + ((size_t)(bh * NBLK + l31)) * 128 + 8 * hh;
#pragma unroll
            for (int ks = 0; ks < 8; ++ks) { const bf16x8 ah = *(const bf16x8*)(kh + 16 * ks), al = *(const bf16x8*)(kl + 16 * ks); ga = MFMA32(ah, qf[ks], ga); ga = MFMA32(al, qf[ks], ga); }
#pragma unroll
            for (int i = 0; i < 16; ++i) gl[l31 * 33 + crow(i, hh)] = ga[i];
            asm volatile("s_waitcnt lgkmcnt(0)" ::: "memory");
            float v0 = -INFINITY, v1 = -INFINITY, v2 = -INFINITY;
            for (int j = 0; j < qb; ++j) { const float gv = gl[l31 * 33 + j];
                if (gv > v0) { v2 = v1; i2 = i1; v1 = v0; i1 = i0; v0 = gv; i0 = j; }
                else if (gv > v1) { v2 = v1; i2 = i1; v1 = gv; i1 = j; }
                else if (gv > v2) { v2 = gv; i2 = j; } }
            asm volatile("s_waitcnt lgkmcnt(0)" ::: "memory");
        }
        __syncthreads();
        unsigned p0 = 0, p1 = 0, p2 = 0;
        if (hh == 0) {
            if (i0 < 32) p0 = __hip_atomic_fetch_add(lcnt + i0, 1u, __ATOMIC_RELAXED, __HIP_MEMORY_SCOPE_WORKGROUP);
            if (i1 < 32) p1 = __hip_atomic_fetch_add(lcnt + i1, 1u, __ATOMIC_RELAXED, __HIP_MEMORY_SCOPE_WORKGROUP);
            if (i2 < 32) p2 = __hip_atomic_fetch_add(lcnt + i2, 1u, __ATOMIC_RELAXED, __HIP_MEMORY_SCOPE_WORKGROUP);
        }
        __syncthreads();
        if (tid < 32) { const unsigned n = lcnt[tid]; lbase[tid] = n ? __hip_atomic_fetch_add(GCNT + bh * 32 + tid, n, __ATOMIC_RELAXED, __HIP_MEMORY_SCOPE_AGENT) : 0u; }
        __syncthreads();
        if (hh == 0) {
            const size_t mlb = ((size_t)bh * SEQ + q) * 3;
            if (i0 < 32) LIST[(size_t)(bh * 32 + i0) * 8192 + lbase[i0] + p0] = (unsigned short)(q | (0 << 13)); else ML[mlb + 0] = (f32x2){AT_NEG, 0.f};
            if (i1 < 32) LIST[(size_t)(bh * 32 + i1) * 8192 + lbase[i1] + p1] = (unsigned short)(q | (1 << 13)); else ML[mlb + 1] = (f32x2){AT_NEG, 0.f};
            if (i2 < 32) LIST[(size_t)(bh * 32 + i2) * 8192 + lbase[i2] + p2] = (unsigned short)(q | (2 << 13)); else ML[mlb + 2] = (f32x2){AT_NEG, 0.f};
        }
        __syncthreads();
    }
}

__device__ __forceinline__ void sparse_phase(const Args& a, LAS unsigned char* lds, int G, int c) {
    const int tid = threadIdx.x, lane = tid & 63, wave = tid >> 6, l31 = lane & 31, hh = lane >> 5;
    unsigned char* ws = a.ws;
    const bf16* Qp = (const bf16*)(ws + WS_PROJ); const bf16* Kp = Qp + SPLIT;
    const bf16* VT = (const bf16*)(ws + WS_H + 64 * MiB);
    const unsigned short* LIST = (const unsigned short*)(ws + WS_LIST); f32x2* ML = (f32x2*)(ws + WS_ML); const unsigned* GCNT = (const unsigned*)(ws + WS_GCNT);
    bf16* PO = (bf16*)a.out;
    LAS unsigned char* kb0 = lds; LAS unsigned char* vb0 = lds + 2 * AT_KBUF;
    LAS unsigned* pref = (LAS unsigned*)(lds + 2 * AT_KBUF + 2 * AT_VBUF);
    LAS unsigned* wtot = pref + 1032;
    {
        const unsigned n0 = GCNT[2 * tid], n1 = GCNT[2 * tid + 1]; const unsigned t0 = (n0 + 255u) >> 8, t1 = (n1 + 255u) >> 8;
        unsigned v = t0 + t1, inc = v;
#pragma unroll
        for (int o = 1; o < 64; o <<= 1) { const unsigned y = __shfl_up(inc, o); if (lane >= o) inc += y; }
        if (lane == 63) wtot[wave] = inc;
        __syncthreads();
        unsigned off = 0;
        for (int w = 0; w < wave; ++w) off += wtot[w];
        const unsigned excl = off + inc - v;
        pref[2 * tid] = excl; pref[2 * tid + 1] = excl + t0;
        if (tid == 511) pref[1024] = excl + v;
        __syncthreads();
    }
    const int total = (int)pref[1024];
    for (int it = c; it < total; it += G) {
        int lo = 0, hi = 1024;
        while (hi - lo > 1) { const int mid = (lo + hi) >> 1; if ((int)pref[mid] <= it) lo = mid; else hi = mid; }
        const int e = lo, tile = it - (int)pref[e], bh = e >> 5, j = e & 31, b = bh >> 3, h = bh & 7;
        const int n = (int)GCNT[e];
        const int idx = tile * 256 + wave * 32 + l31; const bool valid = idx < n;
        const unsigned ent = LIST[(size_t)e * 8192 + (valid ? idx : tile * 256)];
        const int q = ent & 8191, slot = ent >> 13;
        bf16x8 qf[8];
#pragma unroll
        for (int ks = 0; ks < 8; ++ks) qf[ks] = *(const bf16x8*)(Qp + ((size_t)b * SEQ + q) * 1024 + h * 128 + 16 * ks + 8 * hh);
        f32x16 ot[4];
#pragma unroll
        for (int dt = 0; dt < 4; ++dt)
#pragma unroll
            for (int i = 0; i < 16; ++i) ot[dt][i] = 0.f;
        float mrow = AT_NEG, lsum = 0.f;
        const bf16* kg = Kp + ((size_t)b * SEQ) * 1024 + h * 128; const bf16* vg = VT + ((size_t)bh * 128) * SEQ;
        u32x4 kr[2], vr[2];
        AT_LOAD(4 * j); AT_WRITE(0); __syncthreads();
#pragma unroll 1
        for (int t4 = 0; t4 < 4; ++t4) {
            const int buf = t4 & 1;
            if (t4 < 3) AT_LOAD(4 * j + t4 + 1);
            att_tile<false>(kb0 + buf * AT_KBUF, vb0 + buf * AT_VBUF, qf, ot, mrow, lsum, t4, 0, l31, hh);
            if (t4 < 3) AT_WRITE(buf ^ 1);
            __syncthreads();
        }
        lsum += __shfl_xor(lsum, 32);
        if (valid) {
            const float inv = 1.0f / lsum; const size_t pb = ((size_t)bh * SEQ + q) * 3 + slot;
            bf16* op = PO + pb * 128;
#pragma unroll
            for (int dt = 0; dt < 4; ++dt)
#pragma unroll
                for (int g4 = 0; g4 < 4; ++g4) { u32x2 w; w.x = cvtpk(ot[dt][4 * g4] * inv, ot[dt][4 * g4 + 1] * inv); w.y = cvtpk(ot[dt][4 * g4 + 2] * inv, ot[dt][4 * g4 + 3] * inv);
                    *(u32x2*)(op + 32 * dt + 8 * g4 + 4 * hh) = w; }
            if (hh == 0) ML[pb] = (f32x2){mrow, lsum};
        }
    }
}

__device__ __forceinline__ void diag_phase(const Args& a, LAS unsigned char* lds, int G, int c) {
    const int tid = threadIdx.x, lane = tid & 63, wave = tid >> 6, l31 = lane & 31, hh = lane >> 5;
    unsigned char* ws = a.ws;
    const bf16* Qp = (const bf16*)(ws + WS_PROJ); const bf16* Kp = Qp + SPLIT;
    const bf16* VT = (const bf16*)(ws + WS_H + 64 * MiB);
    const f32x2* ML = (const f32x2*)(ws + WS_ML); const bf16* PO = (const bf16*)a.out;
    bf16* OA = (bf16*)(ws + WS_H);
    LAS unsigned char* kb0 = lds; LAS unsigned char* vb0 = lds + 2 * AT_KBUF;
    for (int u = c; u < BATCH * NH * NBLK; u += G) {
        const int bh = u >> 5, qb = u & 31, b = bh >> 3, h = bh & 7;
        const int q = qb * 256 + wave * 32 + l31, qloc = wave * 32 + l31;
        bf16x8 qf[8];
#pragma unroll
        for (int ks = 0; ks < 8; ++ks) qf[ks] = *(const bf16x8*)(Qp + ((size_t)b * SEQ + q) * 1024 + h * 128 + 16 * ks + 8 * hh);
        const size_t pb = ((size_t)bh * SEQ + q) * 3;
        const f32x2 ml0 = ML[pb], ml1 = ML[pb + 1], ml2 = ML[pb + 2];
        f32x16 ot[4];
#pragma unroll
        for (int dt = 0; dt < 4; ++dt)
#pragma unroll
            for (int i = 0; i < 16; ++i) ot[dt][i] = 0.f;
        float mrow = AT_NEG, lsum = 0.f;
        const bf16* kg = Kp + ((size_t)b * SEQ) * 1024 + h * 128; const bf16* vg = VT + ((size_t)bh * 128) * SEQ;
        u32x4 kr[2], vr[2];
        AT_LOAD(4 * qb); AT_WRITE(0); __syncthreads();
#pragma unroll 1
        for (int t4 = 0; t4 < 4; ++t4) {
            const int buf = t4 & 1;
            if (t4 < 3) AT_LOAD(4 * qb + t4 + 1);
            if (t4 <= (wave >> 1)) att_tile<true>(kb0 + buf * AT_KBUF, vb0 + buf * AT_VBUF, qf, ot, mrow, lsum, t4, qloc, l31, hh);
            if (t4 < 3) AT_WRITE(buf ^ 1);
            __syncthreads();
        }
        lsum += __shfl_xor(lsum, 32);
        float M = mrow;
        if (ml0.y > 0.f) M = fmaxf(M, ml0.x);
        if (ml1.y > 0.f) M = fmaxf(M, ml1.x);
        if (ml2.y > 0.f) M = fmaxf(M, ml2.x);
        const float wd = __builtin_amdgcn_exp2f((mrow - M) * AT_CS);
        const float w0 = (ml0.y > 0.f) ? ml0.y * __builtin_amdgcn_exp2f((ml0.x - M) * AT_CS) : 0.f;
        const float w1 = (ml1.y > 0.f) ? ml1.y * __builtin_amdgcn_exp2f((ml1.x - M) * AT_CS) : 0.f;
        const float w2 = (ml2.y > 0.f) ? ml2.y * __builtin_amdgcn_exp2f((ml2.x - M) * AT_CS) : 0.f;
        const float inv = 1.0f / (lsum * wd + w0 + w1 + w2);
        const float cd = wd * inv, c0 = w0 * inv, c1 = w1 * inv, c2 = w2 * inv;
        const bf16* pp = PO + pb * 128;
        bf16* op = OA + ((size_t)b * SEQ + q) * 1024 + h * 128;
#pragma unroll
        for (int dt = 0; dt < 4; ++dt)
#pragma unroll
            for (int g4 = 0; g4 < 4; ++g4) { const int d0 = 32 * dt + 8 * g4 + 4 * hh;
                float r0 = ot[dt][4 * g4] * cd, r1 = ot[dt][4 * g4 + 1] * cd, r2 = ot[dt][4 * g4 + 2] * cd, r3 = ot[dt][4 * g4 + 3] * cd;
                if (c0 > 0.f) { const u32x2 w = *(const u32x2*)(pp + d0); r0 += c0 * bflo(w.x); r1 += c0 * bfhi(w.x); r2 += c0 * bflo(w.y); r3 += c0 * bfhi(w.y); }
                if (c1 > 0.f) { const u32x2 w = *(const u32x2*)(pp + 128 + d0); r0 += c1 * bflo(w.x); r1 += c1 * bfhi(w.x); r2 += c1 * bflo(w.y); r3 += c1 * bfhi(w.y); }
                if (c2 > 0.f) { const u32x2 w = *(const u32x2*)(pp + 256 + d0); r0 += c2 * bflo(w.x); r1 += c2 * bfhi(w.x); r2 += c2 * bflo(w.y); r3 += c2 * bfhi(w.y); }
                *(u32x2*)(op + d0) = (u32x2){cvtpk(r0, r1), cvtpk(r2, r3)}; }
    }
}
#undef AT_LOAD
#undef AT_WRITE
#define HG_LOAD(dst, P, u_) do { const int bh_ = (u_) >> 7, cc_ = (u_) & 127; const bf16* src_ = (P) + ((size_t)(bh_ >> 3) * SEQ + cc_ * 64) * 1024 + (bh_ & 7) * 128; \
        _Pragma("unroll") for (int k2 = 0; k2 < 2; ++k2) { const int id = tid + 512 * k2; dst[k2] = *(const u32x4*)(src_ + (size_t)(id >> 4) * 1024 + (id & 15) * 8); } } while (0)
#define HG_STAGE(L, src) do { _Pragma("unroll") for (int k2 = 0; k2 < 2; ++k2) { const int id = tid + 512 * k2; *(LAS u32x4*)((L) + (id >> 4) * 272 + (id & 15) * 16) = src[k2]; } } while (0)
__device__ __forceinline__ void hgrn_passA(const Args& a, LAS unsigned char* lds, int G, int c) {
    const int tid = threadIdx.x, lane = tid & 63, wave = tid >> 6, l31 = lane & 31, hh = lane >> 5, tg = tid >> 7, d = tid & 127;
    unsigned char* ws = a.ws;
    const bf16* Fp = (const bf16*)(ws + WS_PROJ) + 4 * SPLIT; const bf16* Ip = (const bf16*)(ws + WS_PROJ) + 5 * SPLIT;
    const float* lb = (const float*)(ws + WS_LB); float* decay = (float*)(ws + WS_DECAY); float* DS = a.out;
    LAS unsigned char* FS = lds; LAS unsigned char* IS = lds + 17408;
    LAS unsigned char* KT = lds + 34816; LAS unsigned char* VTl = lds + 53248; LAS float* tot = (LAS float*)(lds + 71680);
    constexpr int NU = BATCH * NH * NCH;
    u32x4 fr[2], ir[2];
    if (c < NU) { HG_LOAD(fr, Fp, c); HG_LOAD(ir, Ip, c); }
    for (int u = c; u < NU; u += G) {
        const int bh = u >> 7, h = bh & 7;
        HG_STAGE(FS, fr); HG_STAGE(IS, ir);
        __syncthreads();
        if (u + G < NU) { HG_LOAD(fr, Fp, u + G); HG_LOAD(ir, Ip, u + G); }
        const float lbv = lb[h * 128 + d];
        float bb[16], kk[16]; float cum = 0.f;
#pragma unroll
        for (int k = 0; k < 16; ++k) { const float fp = bf2f(*(const LAS bf16*)(FS + (16 * tg + k) * 272 + 2 * d)); const float f = lbv + (1.f - lbv) * sigm(fp); cum += __logf(f); bb[k] = cum; kk[k] = 1.f - f; }
        tot[tg * 128 + d] = cum;
        unsigned vw[8];
#pragma unroll
        for (int k = 0; k < 8; ++k) vw[k] = (unsigned)*(const LAS bf16*)(IS + (16 * tg + 2 * k) * 272 + 2 * d) | ((unsigned)*(const LAS bf16*)(IS + (16 * tg + 2 * k + 1) * 272 + 2 * d) << 16);
        __syncthreads();
        const float t0 = tot[d], t1 = tot[128 + d], t2 = tot[256 + d], t3 = tot[384 + d];
        const float off = (tg > 0 ? t0 : 0.f) + (tg > 1 ? t1 : 0.f) + (tg > 2 ? t2 : 0.f), total = (t0 + t1) + (t2 + t3);
        unsigned kw[8];
#pragma unroll
        for (int k = 0; k < 8; ++k) kw[k] = cvtpk(kk[2 * k] * __expf(total - (off + bb[2 * k])), kk[2 * k + 1] * __expf(total - (off + bb[2 * k + 1])));
        *(LAS u32x4*)(KT + d * 144 + tg * 32) = (u32x4){kw[0], kw[1], kw[2], kw[3]}; *(LAS u32x4*)(KT + d * 144 + tg * 32 + 16) = (u32x4){kw[4], kw[5], kw[6], kw[7]};
        *(LAS u32x4*)(VTl + d * 144 + tg * 32) = (u32x4){vw[0], vw[1], vw[2], vw[3]}; *(LAS u32x4*)(VTl + d * 144 + tg * 32 + 16) = (u32x4){vw[4], vw[5], vw[6], vw[7]};
        if (tg == 0) decay[(size_t)u * 128 + d] = __expf(total);
        __syncthreads();
        const int vt = wave >> 1;
#pragma unroll
        for (int dd = 0; dd < 2; ++dd) { const int dtile = 2 * (wave & 1) + dd;
            f32x16 acc;
#pragma unroll
            for (int i = 0; i < 16; ++i) acc[i] = 0.f;
#pragma unroll
            for (int ks = 0; ks < 4; ++ks) { const bf16x8 af = *(const LAS bf16x8*)(VTl + (32 * vt + l31) * 144 + 32 * ks + 16 * hh), bfr = *(const LAS bf16x8*)(KT + (32 * dtile + l31) * 144 + 32 * ks + 16 * hh);
                acc = MFMA32(af, bfr, acc); }
            float* o = DS + ((size_t)u * 128) * 128 + 32 * dtile + l31;
#pragma unroll
            for (int i = 0; i < 16; ++i) o[(size_t)(32 * vt + crow(i, hh)) * 128] = acc[i];
        }
    }
    __syncthreads();
}
__device__ __forceinline__ void hgrn_passB(const Args& a, int G, int c) {
    const float* decay = (const float*)(a.ws + WS_DECAY); float* DS = a.out;
    for (int e = c * NTHR + (int)threadIdx.x; e < 32 * 128 * 32; e += G * NTHR) {
        const int bh = e >> 12, v = (e >> 5) & 127, d4 = e & 31;
        f32x4 S = {0.f, 0.f, 0.f, 0.f};
        float* p = DS + ((size_t)bh * NCH * 128 + v) * 128 + 4 * d4; const float* dc = decay + (size_t)bh * NCH * 128 + 4 * d4;
#pragma unroll 1
        for (int cc = 0; cc < NCH; cc += 16) {
            f32x4 dv[16], de[16];
#pragma unroll
            for (int k = 0; k < 16; ++k) { dv[k] = __builtin_nontemporal_load((const f32x4*)(p + (size_t)(cc + k) * 16384)); de[k] = *(const f32x4*)(dc + (size_t)(cc + k) * 128); }
#pragma unroll
            for (int k = 0; k < 16; ++k) { *(f32x4*)(p + (size_t)(cc + k) * 16384) = S; S = de[k] * S + dv[k]; }
        }
    }
}
__device__ __forceinline__ void hgrn_passC(const Args& a, LAS unsigned char* lds, int G, int c) {
    const int tid = threadIdx.x, lane = tid & 63, wave = tid >> 6, l31 = lane & 31, hh = lane >> 5, tg = tid >> 7, d = tid & 127;
    unsigned char* ws = a.ws;
    const bf16* Qr = (const bf16*)(ws + WS_PROJ) + 3 * SPLIT; const bf16* Fp = Qr + SPLIT; const bf16* Ip = Qr + 2 * SPLIT; const bf16* Gr = Qr + 3 * SPLIT;
    const float* lb = (const float*)(ws + WS_LB); const float* SP = a.out;
    bf16* ORp = (bf16*)(ws + WS_PROJ) + 6 * SPLIT;
    LAS unsigned char* QS = lds; LAS unsigned char* FS = lds + 17408; LAS unsigned char* IS = lds + 34816;
    LAS unsigned char* QT = lds + 52224; LAS unsigned char* KTl = lds + 69632; LAS unsigned char* QE = lds + 87040; LAS unsigned char* VTl = lds + 104448;
    LAS float* tot = (LAS float*)(lds + 122880); LAS float* ssq = (LAS float*)(lds + 124928);
    constexpr int NU = BATCH * NH * NCH;
    const int tt = wave & 1, vt = wave >> 1;
    u32x4 qr[2], fr[2], ir[2];
    if (c < NU) { HG_LOAD(qr, Qr, c); HG_LOAD(fr, Fp, c); HG_LOAD(ir, Ip, c); }
    for (int u = c; u < NU; u += G) {
        const int bh = u >> 7, cc = u & 127, b = bh >> 3, h = bh & 7; const size_t tokc = (size_t)b * SEQ + cc * 64;
        HG_STAGE(QS, qr); HG_STAGE(FS, fr); HG_STAGE(IS, ir);
        f32x4 sv[16];
        { const float* sp = SP + ((size_t)u * 128 + 32 * vt + l31) * 128 + 8 * hh;
#pragma unroll
          for (int ks = 0; ks < 8; ++ks) { sv[2 * ks] = __builtin_nontemporal_load((const f32x4*)(sp + 16 * ks)); sv[2 * ks + 1] = __builtin_nontemporal_load((const f32x4*)(sp + 16 * ks + 4)); } }
        const int t = 32 * tt + l31;
        u32x2 gw[4];
#pragma unroll
        for (int g4 = 0; g4 < 4; ++g4) gw[g4] = *(const u32x2*)(Gr + (tokc + t) * 1024 + h * 128 + 32 * vt + 8 * g4 + 4 * hh);
        __syncthreads();
        if (u + G < NU) { HG_LOAD(qr, Qr, u + G); HG_LOAD(fr, Fp, u + G); HG_LOAD(ir, Ip, u + G); }
        const float lbv = lb[h * 128 + d];
        float bb[16], kk[16], qv[16]; float cum = 0.f;
#pragma unroll
        for (int k = 0; k < 16; ++k) { const float fp = bf2f(*(const LAS bf16*)(FS + (16 * tg + k) * 272 + 2 * d)); const float f = lbv + (1.f - lbv) * sigm(fp); cum += __logf(f); bb[k] = cum; kk[k] = 1.f - f;
            const float q = bf2f(*(const LAS bf16*)(QS + (16 * tg + k) * 272 + 2 * d)); qv[k] = q * sigm(q); }
        tot[tg * 128 + d] = cum;
        unsigned vw[8];
#pragma unroll
        for (int k = 0; k < 8; ++k) vw[k] = (unsigned)*(const LAS bf16*)(IS + (16 * tg + 2 * k) * 272 + 2 * d) | ((unsigned)*(const LAS bf16*)(IS + (16 * tg + 2 * k + 1) * 272 + 2 * d) << 16);
        __syncthreads();
        const float t0 = tot[d], t1 = tot[128 + d], t2 = tot[256 + d];
        const float off = (tg > 0 ? t0 : 0.f) + (tg > 1 ? t1 : 0.f) + (tg > 2 ? t2 : 0.f), bref = t0 + t1;
#pragma unroll
        for (int k = 0; k < 16; ++k) { const float bt = off + bb[k]; const int tk = 16 * tg + k;
            const float e1 = __expf(fminf(bt - bref, 80.f)), e2 = __expf(fminf(bref - bt, 80.f)), e3 = __expf(bt);
            const unsigned w1 = cvtpk(qv[k] * e1, kk[k] * e2), w2 = cvtpk(qv[k] * e3, 0.f);
            *(LAS bf16*)(QT + tk * 272 + 2 * d) = (bf16)(w1 & 0xffffu); *(LAS bf16*)(KTl + tk * 272 + 2 * d) = (bf16)(w1 >> 16); *(LAS bf16*)(QE + tk * 272 + 2 * d) = (bf16)(w2 & 0xffffu); }
        *(LAS u32x4*)(VTl + d * 144 + tg * 32) = (u32x4){vw[0], vw[1], vw[2], vw[3]}; *(LAS u32x4*)(VTl + d * 144 + tg * 32 + 16) = (u32x4){vw[4], vw[5], vw[6], vw[7]};
        __syncthreads();
        f32x16 o;
#pragma unroll
        for (int i = 0; i < 16; ++i) o[i] = 0.f;
#pragma unroll
        for (int sh = 0; sh < 2; ++sh) {
            if (sh <= tt) {
                f32x16 sc;
#pragma unroll
                for (int i = 0; i < 16; ++i) sc[i] = 0.f;
#pragma unroll
                for (int ks = 0; ks < 8; ++ks) { const bf16x8 af = *(const LAS bf16x8*)(KTl + (32 * sh + l31) * 272 + 32 * ks + 16 * hh), bfr = *(const LAS bf16x8*)(QT + (32 * tt + l31) * 272 + 32 * ks + 16 * hh);
                    sc = MFMA32(af, bfr, sc); }
#pragma unroll
                for (int i = 0; i < 16; ++i) { const int s = 32 * sh + crow(i, hh); sc[i] = (s <= t) ? sc[i] : 0.f; }
#pragma unroll
                for (int s2 = 0; s2 < 2; ++s2) { const bf16x8 pf = pack8(sc, s2);
                    const LAS unsigned char* vp = VTl + (32 * vt + l31) * 144 + (32 * sh + 16 * s2 + 4 * hh) * 2;
                    const u32x2 x0 = *(const LAS u32x2*)vp, x1 = *(const LAS u32x2*)(vp + 16); const u32x4 xv = {x0.x, x0.y, x1.x, x1.y};
                    o = MFMA32(__builtin_bit_cast(bf16x8, xv), pf, o); }
            }
        }
#pragma unroll
        for (int ks = 0; ks < 8; ++ks) { const f32x4 s0 = sv[2 * ks], s1 = sv[2 * ks + 1];
            const u32x4 sw = {cvtpk(s0.x, s0.y), cvtpk(s0.z, s0.w), cvtpk(s1.x, s1.y), cvtpk(s1.z, s1.w)};
            const bf16x8 bfr = *(const LAS bf16x8*)(QE + (32 * tt + l31) * 272 + 32 * ks + 16 * hh);
            o = MFMA32(__builtin_bit_cast(bf16x8, sw), bfr, o); }
        float sq = 0.f;
#pragma unroll
        for (int i = 0; i < 16; ++i) sq += o[i] * o[i];
        sq += __shfl_xor(sq, 32);
        if (hh == 0) ssq[vt * 64 + t] = sq;
        __syncthreads();
        const float rstd = rsqrtf(((ssq[t] + ssq[64 + t]) + (ssq[128 + t] + ssq[192 + t])) * (1.f / 128.f) + EPS);
#pragma unroll
        for (int g4 = 0; g4 < 4; ++g4) { const int v0 = 32 * vt + 8 * g4 + 4 * hh;
            const f32x4 gn = *(const f32x4*)(a.hg_g + v0);
            const float r0 = o[4 * g4] * rstd * gn.x * sigm(bflo(gw[g4].x)), r1 = o[4 * g4 + 1] * rstd * gn.y * sigm(bfhi(gw[g4].x)), r2 = o[4 * g4 + 2] * rstd * gn.z * sigm(bflo(gw[g4].y)), r3 = o[4 * g4 + 3] * rstd * gn.w * sigm(bfhi(gw[g4].y));
            *(u32x2*)(ORp + (tokc + t) * 1024 + h * 128 + v0) = (u32x2){cvtpk(r0, r1), cvtpk(r2, r3)}; }
    }
    __syncthreads();
}
#undef HG_LOAD
#undef HG_STAGE
__global__ void __launch_bounds__(NTHR, 2) mega(Args a) {
    extern __shared__ __attribute__((aligned(16))) unsigned char lds_raw[];
    LAS unsigned char* lds = (LAS unsigned char*)lds_raw;
    const int G = gridDim.x, c = blockIdx.x;
    unsigned char* ws = a.ws;
    const int lo = a.ph_lo, hi = a.ph_hi;
#define IN(k) (lo <= (k) && (k) < hi)
#define SEAM(k) do { if (a.coop && IN((k) + 1) && IN(k)) { cg::this_grid().sync(); } } while (0)
    bf16* PROJ = (bf16*)(ws + WS_PROJ);
    if (IN(0)) { p0_prologue(a, lds, G, c); __syncthreads(); } SEAM(0);
    if (IN(1)) { pg8::Gemm g{(const bf16*)(ws + WS_H), (const bf16*)(ws + WS_WIN), T, DIN, DM}; pg8::StaticOrder S; S.init(T, DIN, G, c);
        pg8::EpiBf16<0> E{PROJ, 1024, 1024, SPLIT, nullptr}; pg8::gemm_phase<pg8::EpiBf16<0>, pg8::StaticOrder>(lds, g, S, E, nullptr); } SEAM(1);
    if (IN(2)) { p2_qkprep(a, lds, G, c); hgrn_passA(a, lds, G, c); } SEAM(2);
    if (IN(3)) { sel_phase(a, lds, G, c); hgrn_passB(a, G, c); } SEAM(3);
    if (IN(4)) { hgrn_passC(a, lds, G, c); } SEAM(4);
    if (IN(5)) { sparse_phase(a, lds, G, c); } SEAM(5);
    if (IN(6)) { diag_phase(a, lds, G, c); } SEAM(6);
    if (IN(7)) { { pg8::Gemm g{(const bf16*)(ws + WS_H), (const bf16*)(ws + WS_WUPA), T, DM, AW}; pg8::StaticOrder S; S.init(T, DM, G, c);
        pg8::EpiGate E{PROJ + 7 * SPLIT, SPLIT, a.b_gate, PROJ, DM, 0}; pg8::gemm_phase<pg8::EpiGate, pg8::StaticOrder>(lds, g, S, E, nullptr); }
      { pg8::Gemm g{PROJ + 6 * SPLIT, (const bf16*)(ws + WS_WUPR), T, DM, AW}; pg8::StaticOrder S; S.init(T, DM, G, c);
        pg8::EpiGate E{PROJ + 9 * SPLIT, SPLIT, a.b_gate + DM, PROJ, DM, 1}; pg8::gemm_phase<pg8::EpiGate, pg8::StaticOrder>(lds, g, S, E, nullptr); } } SEAM(7);
    if (IN(8)) { pg8::Gemm g{PROJ, (const bf16*)(ws + WS_WOUT), T, DM, DM}; pg8::StaticOrder S; S.init(T, DM, G, c);
        pg8::EpiResid E{a.x, a.out, DM}; pg8::gemm_phase<pg8::EpiResid, pg8::StaticOrder>(lds, g, S, E, nullptr); } SEAM(8);
    if (IN(9)) { const int wave = threadIdx.x >> 6, lane = threadIdx.x & 63; bf16* Hb = (bf16*)(ws + WS_H);
        for (int m = c * NWAVES + wave; m < T; m += G * NWAVES) rms_row_to_bf16(a.out + (size_t)m * DM, a.mlp_g, Hb + (size_t)m * DM, lane); } SEAM(9);
    if (IN(10)) { pg8::Gemm g{(const bf16*)(ws + WS_H), (const bf16*)(ws + WS_W1), T, FF, DM}; pg8::StaticOrder S; S.init(T, FF, G, c);
        pg8::EpiBf16<1> E{PROJ + 3 * SPLIT, FF, 0, 0, nullptr}; pg8::gemm_phase<pg8::EpiBf16<1>, pg8::StaticOrder>(lds, g, S, E, nullptr); } SEAM(10);
    if (IN(11)) { pg8::Gemm g{PROJ + 3 * SPLIT, (const bf16*)(ws + WS_W2), T, DM, FF}; pg8::StaticOrder S; S.init(T, DM, G, c);
        pg8::EpiResid E{a.out, a.out, DM}; pg8::gemm_phase<pg8::EpiResid, pg8::StaticOrder>(lds, g, S, E, nullptr); }
#undef IN
#undef SEAM
}

#ifndef MK_SINGLE
#define MK_SINGLE 1
#endif
constexpr int NPHASE = 12;
extern "C" void kernel_launch(void* const* d_in, const int* in_sizes, int n_in, void* d_out, int out_size, void* d_ws, size_t ws_size, hipStream_t stream) {
    static int grid = 0;
    if (grid == 0) {
        if (n_in != 14 || in_sizes[0] != T * DM || out_size != T * DM || ws_size < 985 * MiB) { fprintf(stderr, "kernel_launch: unexpected shapes / workspace (n_in %d in0 %d out %d ws %zu)\n", n_in, n_in > 0 ? in_sizes[0] : -1, out_size, ws_size); grid = -1; return; }
        int dev = 0, cus = 0, per_cu = 0;
        if (hipGetDevice(&dev) != hipSuccess || hipDeviceGetAttribute(&cus, hipDeviceAttributeMultiprocessorCount, dev) != hipSuccess) { grid = -1; return; }
        if (hipFuncSetAttribute((const void*)mega, hipFuncAttributeMaxDynamicSharedMemorySize, LDS_BYTES) != hipSuccess) { fprintf(stderr, "kernel_launch: hipFuncSetAttribute failed\n"); grid = -1; return; }
        if (hipOccupancyMaxActiveBlocksPerMultiprocessor(&per_cu, (const void*)mega, NTHR, LDS_BYTES) != hipSuccess || per_cu < 1) { fprintf(stderr, "kernel_launch: occupancy query says %d\n", per_cu); per_cu = 1; }
        (void)hipGetLastError();
        grid = cus * per_cu;
    }
    if (grid < 0) return;
    Args a{};
    a.x = (const float*)d_in[0]; a.w_in = (const float*)d_in[1]; a.b_gate = (const float*)d_in[2]; a.attn_g = (const float*)d_in[3]; a.qn_g = (const float*)d_in[4]; a.kn_g = (const float*)d_in[5];
    a.lb_logits = (const float*)d_in[6]; a.hg_g = (const float*)d_in[7]; a.w_up_a = (const float*)d_in[8]; a.w_up_r = (const float*)d_in[9]; a.w_out = (const float*)d_in[10]; a.mlp_g = (const float*)d_in[11];
    a.w_mlp1 = (const float*)d_in[12]; a.w_mlp2 = (const float*)d_in[13];
    a.out = (float*)d_out; a.ws = (unsigned char*)d_ws;
#if MK_SINGLE
    a.ph_lo = 0; a.ph_hi = NPHASE; a.coop = 1;
    void* args[] = {&a};
    hipError_t e = hipLaunchCooperativeKernel((const void*)mega, dim3(grid), dim3(NTHR), args, LDS_BYTES, stream);
    if (e != hipSuccess) fprintf(stderr, "kernel_launch: cooperative launch failed: %s (grid %d)\n", hipGetErrorString(e), grid);
#else
    for (int p = 0; p < NPHASE; ++p) { a.ph_lo = p; a.ph_hi = p + 1; a.coop = 0; hipLaunchKernelGGL(mega, dim3(grid), dim3(NTHR), LDS_BYTES, stream, a); }
#endif
}
```
